# Optimizing an MI355X kernel written in HIP

```python
import math
import numpy as np
import jax
import jax.numpy as jnp
from jax import lax


D_MODEL = 1024
BATCH = 8
SEQ = 4096
DEPTH = 2

PLE_DIM = 256
GRID_W = 64
BRANCH_W = 512
N_BRANCH = 4
N_IN = 10 * BRANCH_W + N_BRANCH * D_MODEL
NORM_EPS = 1e-6
LRU_BLOCKS = 8
LRU_BLOCK_DIM = BRANCH_W // LRU_BLOCKS
LRU_CONV_W = 4
LRU_C = 8.0
NA_HEADS = 8
NA_HEAD_DIM = BRANCH_W // NA_HEADS
NA_ROWS_MAX = 8
NA_COLS = 16
NA_COL_BLOCKS = GRID_W // NA_COLS
NA_BAND = 2 * NA_COLS
SSM_GROUP = 16
SSM_GROUPS = BRANCH_W // SSM_GROUP
SSM_STATE = 64
POOL_WINDOWS = (2, 4, 8, 16)
POOL_GROUP = BRANCH_W // 4

kernel_name = 'hybrid_lru_natten_s5_pool_encoder'


def rms_norm(x, g):
    x32 = x.astype(jnp.float32)
    y = x32 * lax.rsqrt(jnp.mean(x32 * x32, axis=-1, keepdims=True) + NORM_EPS)
    return (y * g.astype(jnp.float32)).astype(x.dtype)


def _linear_combine(left, right):
    a1, b1 = left
    a2, b2 = right
    return a1 * a2, a2 * b1 + b2


def _complex_combine(left, right):
    a1r, a1i, b1r, b1i = left
    a2r, a2i, b2r, b2i = right
    return (a1r * a2r - a1i * a2i,
            a1r * a2i + a1i * a2r,
            a2r * b1r - a2i * b1i + b2r,
            a2r * b1i + a2i * b1r + b2i)


def _rglru_direction(xc, w_r, b_r, w_i, b_i, lam, reverse):
    bsz, s, w = xc.shape
    xb = xc.reshape(bsz, s, LRU_BLOCKS, LRU_BLOCK_DIM)
    r = jax.nn.sigmoid(jnp.einsum('bsnc,ncd->bsnd', xb, w_r).reshape(bsz, s, w) + b_r)
    gi = jax.nn.sigmoid(jnp.einsum('bsnc,ncd->bsnd', xb, w_i).reshape(bsz, s, w) + b_i)
    log_a = -LRU_C * r * jax.nn.softplus(-lam)
    a = jnp.exp(log_a)
    b = jnp.sqrt(-jnp.expm1(2.0 * log_a)) * (gi * xc)
    _, h = lax.associative_scan(_linear_combine, (a, b), axis=1, reverse=reverse)
    return h


def rglru_mixer(u, conv_w, conv_b, w_r, b_r, w_i, b_i, lam):
    f32 = jnp.float32
    w = u.shape[-1]
    pad_l = LRU_CONV_W // 2
    xc = lax.conv_general_dilated(u.astype(f32), conv_w.astype(f32)[:, None, :], window_strides=(1,),
                                  padding=[(pad_l, LRU_CONV_W - 1 - pad_l)],
                                  dimension_numbers=('NWC', 'WIO', 'NWC'),
                                  feature_group_count=w) + conv_b.astype(f32)
    h_f = _rglru_direction(xc, w_r[0].astype(f32), b_r[0].astype(f32), w_i[0].astype(f32),
                           b_i[0].astype(f32), lam[0].astype(f32), False)
    h_b = _rglru_direction(xc, w_r[1].astype(f32), b_r[1].astype(f32), w_i[1].astype(f32),
                           b_i[1].astype(f32), lam[1].astype(f32), True)
    return h_f + h_b


def neighbourhood_attention(q, k, v, q_gain, k_gain, rpb):
    f32 = jnp.float32
    bsz, s, w = q.shape
    rows = s // GRID_W
    kr = min(NA_ROWS_MAX, rows)
    h, dh = NA_HEADS, NA_HEAD_DIM
    qn = rms_norm(q.reshape(bsz, s, h, dh), q_gain).astype(f32) * (dh ** -0.5)
    kn = rms_norm(k.reshape(bsz, s, h, dh), k_gain).astype(f32)
    qg = qn.reshape(bsz, rows, NA_COL_BLOCKS, NA_COLS, h, dh)
    kg = kn.reshape(bsz, rows, GRID_W, h, dh)
    vg = v.astype(f32).reshape(bsz, rows, GRID_W, h, dh)
    qcol = np.arange(GRID_W).reshape(NA_COL_BLOCKS, NA_COLS)
    band_start = np.clip(qcol[:, 0] - NA_COLS // 2, 0, GRID_W - NA_BAND)
    kcol = band_start[:, None] + np.arange(NA_BAND)
    win_start = np.clip(qcol - NA_COLS // 2, 0, GRID_W - NA_COLS)
    col_mask = ((kcol[:, None, :] >= win_start[:, :, None]) &
                (kcol[:, None, :] < win_start[:, :, None] + NA_COLS))
    dc_idx = np.clip(kcol[:, None, :] - qcol[:, :, None], -(NA_COLS - 1), NA_COLS - 1) + NA_COLS - 1
    rpb32 = rpb.astype(f32)
    mask = jnp.asarray(col_mask)[:, :, None, :]

    def one_row(r):
        rs = jnp.clip(r - kr // 2, 0, rows - kr)
        k_blk = lax.dynamic_slice_in_dim(kg, rs, kr, axis=1)[:, :, kcol]
        v_blk = lax.dynamic_slice_in_dim(vg, rs, kr, axis=1)[:, :, kcol]
        q_r = lax.dynamic_index_in_dim(qg, r, axis=1, keepdims=False)
        sc = jnp.einsum('bjqhd,brjkhd->bhjqrk', q_r, k_blk)
        dr_idx = rs + jnp.arange(kr) - r + NA_ROWS_MAX - 1
        bias = rpb32[:, dr_idx][:, :, dc_idx].transpose(0, 2, 3, 1, 4)
        sc = jnp.where(mask, sc + bias[None], -1e30)
        pr = jax.nn.softmax(sc.reshape(sc.shape[:4] + (kr * NA_BAND,)), axis=-1).reshape(sc.shape)
        return jnp.einsum('bhjqrk,brjkhd->bjqhd', pr, v_blk)

    out = lax.map(one_row, jnp.arange(rows))
    return jnp.moveaxis(out, 0, 1).reshape(bsz, s, w)


def s5_mixer(u, a_re, a_im, log_dt, b_re, b_im, c_re, c_im, d_skip, glu_w, glu_b):
    f32 = jnp.float32
    bsz, s, w = u.shape
    u32 = u.astype(f32)
    ug = u32.reshape(bsz, s, SSM_GROUPS, SSM_GROUP)
    y = u32 * d_skip.astype(f32)
    for d in range(2):
        lr = jnp.minimum(a_re[d].astype(f32), -1e-4)
        li = a_im[d].astype(f32)
        dt = jnp.exp(log_dt[d].astype(f32))[:, None]
        mag = jnp.exp(lr * dt)
        abar_r = mag * jnp.cos(li * dt)
        abar_i = mag * jnp.sin(li * dt)
        nr = abar_r - 1.0
        den = lr * lr + li * li
        fr = ((nr * lr + abar_i * li) / den)[..., None]
        fi = ((abar_i * lr - nr * li) / den)[..., None]
        br_, bi_ = b_re[d].astype(f32), b_im[d].astype(f32)
        bbar_r = fr * br_ - fi * bi_
        bbar_i = fr * bi_ + fi * br_
        bu_r = jnp.einsum('bsgc,gpc->bsgp', ug, bbar_r)
        bu_i = jnp.einsum('bsgc,gpc->bsgp', ug, bbar_i)
        a_r = jnp.broadcast_to(abar_r, (1, s, SSM_GROUPS, SSM_STATE))
        a_i = jnp.broadcast_to(abar_i, (1, s, SSM_GROUPS, SSM_STATE))
        _, _, sr, si = lax.associative_scan(_complex_combine, (a_r, a_i, bu_r, bu_i),
                                            axis=1, reverse=(d == 1))
        yd = (jnp.einsum('bsgp,gcp->bsgc', sr, c_re[d].astype(f32)) -
              jnp.einsum('bsgp,gcp->bsgc', si, c_im[d].astype(f32)))
        y = y + yd.reshape(bsz, s, w)
    yg = jax.nn.gelu(y)
    return yg * jax.nn.sigmoid(yg @ glu_w.astype(f32) + glu_b.astype(f32))


def pool_mixer(u, w_pool, scale):
    f32 = jnp.float32
    bsz, s, w = u.shape
    ug = u.astype(f32).reshape(bsz, s, len(POOL_WINDOWS), POOL_GROUP)
    cs = jnp.pad(jnp.cumsum(ug, axis=1), ((0, 0), (1, 0), (0, 0), (0, 0)))
    t = jnp.arange(s)
    outs = []
    for g, win in enumerate(POOL_WINDOWS):
        lo = jnp.clip(t - win // 2, 0, s)
        hi = jnp.clip(t - win // 2 + win, 0, s)
        cnt = (hi - lo).astype(f32)[None, :, None]
        outs.append((cs[:, hi, g] - cs[:, lo, g]) / cnt - ug[:, :, g])
    pooled = jnp.stack(outs, axis=2)
    mixed = jnp.einsum('bsgc,gcd->bsgd', pooled, w_pool.astype(f32)).reshape(bsz, s, w)
    return mixed * scale.astype(f32)


def setup_inputs(seed: int = 0) -> dict:
    key = jax.random.key(seed)
    k = jax.random.split(key, 32)
    f32 = jnp.float32
    W, G, P, C = BRANCH_W, SSM_GROUPS, SSM_STATE, SSM_GROUP

    def nrm(i, shape, scale):
        return scale * jax.random.normal(k[i], shape, f32)

    u = jax.random.uniform(k[10], (DEPTH, 2, W), f32, minval=0.9, maxval=0.999)
    a0 = u ** (1.0 / LRU_C)
    lam = jnp.log(a0) - jnp.log1p(-a0)
    a_im = jnp.pi * jnp.arange(P, dtype=f32) + nrm(15, (DEPTH, 2, G, P), 0.01)
    log_dt = jax.random.uniform(k[16], (DEPTH, 2, G), f32, minval=math.log(1e-3), maxval=math.log(1e-1))
    return {
        'x': nrm(0, (BATCH, SEQ, D_MODEL), 1.0),
        'p': nrm(1, (DEPTH, BATCH, SEQ, PLE_DIM), 1.0),
        'norm_scale': 1.0 + nrm(2, (DEPTH, D_MODEL), 0.02),
        'w_in': nrm(3, (DEPTH, D_MODEL, N_IN), D_MODEL ** -0.5),
        'lru_conv_w': nrm(4, (DEPTH, LRU_CONV_W, W), LRU_CONV_W ** -0.5),
        'lru_conv_b': nrm(5, (DEPTH, W), 0.01),
        'lru_w_r': nrm(6, (DEPTH, 2, LRU_BLOCKS, LRU_BLOCK_DIM, LRU_BLOCK_DIM), LRU_BLOCK_DIM ** -0.5),
        'lru_b_r': nrm(7, (DEPTH, 2, W), 0.01),
        'lru_w_i': nrm(8, (DEPTH, 2, LRU_BLOCKS, LRU_BLOCK_DIM, LRU_BLOCK_DIM), LRU_BLOCK_DIM ** -0.5),
        'lru_b_i': nrm(9, (DEPTH, 2, W), 0.01),
        'lru_lambda': lam,
        'na_q_gain': 1.0 + nrm(11, (DEPTH, NA_HEAD_DIM), 0.02),
        'na_k_gain': 1.0 + nrm(12, (DEPTH, NA_HEAD_DIM), 0.02),
        'na_rel_bias': nrm(13, (DEPTH, NA_HEADS, 2 * NA_ROWS_MAX - 1, 2 * NA_COLS - 1), 0.02),
        'ssm_a_re': -0.5 + nrm(14, (DEPTH, 2, G, P), 0.01),
        'ssm_a_im': a_im,
        'ssm_log_dt': log_dt,
        'ssm_b_re': nrm(17, (DEPTH, 2, G, P, C), (2 * C) ** -0.5),
        'ssm_b_im': nrm(18, (DEPTH, 2, G, P, C), (2 * C) ** -0.5),
        'ssm_c_re': nrm(19, (DEPTH, 2, G, C, P), P ** -0.5),
        'ssm_c_im': nrm(20, (DEPTH, 2, G, C, P), P ** -0.5),
        'ssm_d': nrm(21, (DEPTH, W), 1.0),
        'ssm_glu_w': nrm(22, (DEPTH, W, W), W ** -0.5),
        'ssm_glu_b': nrm(23, (DEPTH, W), 0.01),
        'pool_w': nrm(24, (DEPTH, len(POOL_WINDOWS), POOL_GROUP, POOL_GROUP), POOL_GROUP ** -0.5),
        'pool_scale': 1.0 + nrm(25, (DEPTH, W), 0.02),
        'w_branch': nrm(26, (DEPTH, N_BRANCH, W, D_MODEL), W ** -0.5),
        'w_out': nrm(27, (DEPTH, D_MODEL, D_MODEL), D_MODEL ** -0.5),
        'ple_proj': nrm(28, (DEPTH, PLE_DIM, D_MODEL), PLE_DIM ** -0.5),
        'ple_gate': nrm(29, (DEPTH, D_MODEL, D_MODEL), D_MODEL ** -0.5),
    }


def reference(x, p, norm_scale, w_in, lru_conv_w, lru_conv_b, lru_w_r, lru_b_r, lru_w_i, lru_b_i,
              lru_lambda, na_q_gain, na_k_gain, na_rel_bias, ssm_a_re, ssm_a_im, ssm_log_dt,
              ssm_b_re, ssm_b_im, ssm_c_re, ssm_c_im, ssm_d, ssm_glu_w, ssm_glu_b, pool_w,
              pool_scale, w_branch, w_out, ple_proj, ple_gate):
    bsz, s, _ = x.shape
    split_points = [BRANCH_W * j for j in range(1, 11)]
    for i in range(DEPTH):
        hn = rms_norm(x, norm_scale[i])
        z = hn @ w_in[i]
        a_x, a_g, q, k, v, b_g, c_x, c_g, d_x, d_g, merge = jnp.split(z, split_points, axis=-1)
        y_a = rglru_mixer(a_x, lru_conv_w[i], lru_conv_b[i], lru_w_r[i], lru_b_r[i],
                          lru_w_i[i], lru_b_i[i], lru_lambda[i]) * jax.nn.silu(a_g)
        y_b = neighbourhood_attention(q, k, v, na_q_gain[i], na_k_gain[i], na_rel_bias[i]) * jax.nn.silu(b_g)
        y_c = s5_mixer(c_x, ssm_a_re[i], ssm_a_im[i], ssm_log_dt[i], ssm_b_re[i], ssm_b_im[i],
                       ssm_c_re[i], ssm_c_im[i], ssm_d[i], ssm_glu_w[i], ssm_glu_b[i]) * jax.nn.silu(c_g)
        y_d = pool_mixer(d_x, pool_w[i], pool_scale[i]) * jax.nn.silu(d_g)
        ys = jnp.stack([y_a, y_b, y_c, y_d], axis=2).astype(x.dtype)
        gates = jax.nn.sigmoid(merge.reshape(bsz, s, N_BRANCH, D_MODEL))
        merged = jnp.sum(jnp.einsum('bsnw,nwd->bsnd', ys, w_branch[i]) * gates, axis=2)
        x = x + (merged @ w_out[i]).astype(x.dtype)
        x = x + jax.nn.sigmoid(x @ ple_gate[i]) * (p[i] @ ple_proj[i])
    return x
```

```cpp
#include <hip/hip_runtime.h>
#include <hip/hip_cooperative_groups.h>
#include <cstdio>
namespace cg = cooperative_groups;

typedef __attribute__((ext_vector_type(8))) short bf16x8;
typedef __attribute__((ext_vector_type(4))) float f32x4;
typedef unsigned short u16;
#define DEVI __device__ __forceinline__

constexpr int T = 32768, NZ = 4608;
constexpr int ZA_X = 0, ZA_G = 512, ZQ = 1024, ZK = 1536, ZV = 2048, ZB_G = 2560, ZC_G = 3072,
              ZD_X = 3584, ZD_G = 4096, ZMRG = 1024, ZYG = 2048;

struct Params {
  const float *x, *p, *norm_scale, *w_in, *conv_w, *conv_b, *w_r, *b_r, *w_i, *b_i, *lam, *q_gain, *k_gain, *rpb,
      *a_re, *a_im, *log_dt, *sb_re, *sb_im, *sc_re, *sc_im, *s_d, *glu_w, *glu_b, *pool_w, *pool_scale, *w_branch,
      *w_out, *ple_proj, *ple_gate;
  float* out;
  u16 *wt_in, *wt_br, *wt_out, *wt_pg, *wt_pp, *wt_glu, *wt_pool, *wt_lr, *wt_li, *hn, *z, *w1, *bg2, *ecar, *ub;
  float *ktab, *lagg, *lcar;
  unsigned* bar;
};

typedef const Params __attribute__((address_space(4)))* KP;
__device__ __forceinline__ KP getP() {
  unsigned long long a = (unsigned long long)__builtin_amdgcn_kernarg_segment_ptr();
  unsigned lo = (unsigned)a, hi = (unsigned)(a >> 32);
  asm volatile("" : "+v"(lo), "+v"(hi));
  lo = __builtin_amdgcn_readfirstlane(lo);
  hi = __builtin_amdgcn_readfirstlane(hi);
  return (KP)(((unsigned long long)hi << 32) | lo);
}
DEVI int tidx() {
  int t = threadIdx.x;
  asm volatile("" : "+v"(t));
  return t;
}
DEVI unsigned pk2(float lo, float hi) {
  unsigned r;
  asm("v_cvt_pk_bf16_f32 %0, %1, %2" : "=v"(r) : "v"(lo), "v"(hi));
  return r;
}
DEVI u16 f2bf(float f) { return (u16)(pk2(f, f) & 0xffffu); }
DEVI float bf2f(u16 h) { return __uint_as_float(((unsigned)h) << 16); }
DEVI float bfs(short h) { return __uint_as_float(((unsigned)(u16)h) << 16); }
DEVI bf16x8 ld8(const u16* p) { return *reinterpret_cast<const bf16x8*>(p); }
DEVI float sigm(float x) { return __builtin_amdgcn_rcpf(1.f + __expf(-x)); }
DEVI float silu(float x) { return x * __builtin_amdgcn_rcpf(1.f + __expf(-x)); }
DEVI float gelu_t(float x) {
  float u = 0.7978845608028654f * (x + 0.044715f * x * x * x);
  float t = 1.f - 2.f * __builtin_amdgcn_rcpf(1.f + __expf(2.f * u));
  return 0.5f * x * (1.f + t);
}
typedef unsigned u32x4_t __attribute__((ext_vector_type(4)));
DEVI bf16x8 pack8(const float* v) {
  u32x4_t r = {pk2(v[0], v[1]), pk2(v[2], v[3]), pk2(v[4], v[5]), pk2(v[6], v[7])};
  return __builtin_bit_cast(bf16x8, r);
}
DEVI f32x4 mfma(bf16x8 a, bf16x8 b, f32x4 c) { return __builtin_amdgcn_mfma_f32_16x16x32_bf16(a, b, c, 0, 0, 0); }


#define LAS __attribute__((address_space(3)))
constexpr int NT = 512;
namespace pg8 {
constexpr int BM = 256, BK = 64, HALF = 128, HTB = HALF * BK * 2, STAGE_BYTES = 8 * HTB, NXCD = 8, WGM = 8;
DEVI int lds_byte(int r, int c) {
  const int st = (r >> 4) * 2 + (c >> 5), rr = r & 15, cc = c & 31, ob = rr * 64 + cc * 2;
  return st * 1024 + (ob ^ (((ob >> 9) & 1) << 5));
}
DEVI void stage_rc(int b, int& R, int& C) {
  const int st = b / 1024, sb = b % 1024, swz = sb ^ (((sb >> 9) & 1) << 5);
  R = (st >> 1) * 16 + swz / 64;
  C = (st & 1) * 32 + (swz % 64) / 2;
}
DEVI int perm32(int rho) { const int n = rho >> 4, i = rho & 15; return 8 * (i >> 2) + 4 * n + (i & 3); }
struct Unit { int pm, pn, g; };
DEVI void tile_of(int L, int nM, int nN, int& pm, int& pn) {
  const int nwg = nM * nN;
  int wgid = L;
  { const int q = nwg / NXCD, r = nwg % NXCD, xcd = wgid % NXCD, off = wgid / NXCD; wgid = (xcd < r ? xcd * (q + 1) : r * (q + 1) + (xcd - r) * q) + off; }
  const int nig = WGM * nN, gid = wgid / nig, fm = gid * WGM, gsz = (nM - fm) < WGM ? (nM - fm) : WGM;
  pm = fm + ((wgid % nig) % gsz);
  pn = (wgid % nig) / gsz;
}
struct SchedStd {
  const char* A; const char* B; unsigned lda2, ldb2; int nM, nN, c, G;
  DEVI bool next(int i, Unit& u) const {
    const int L = i * G + c;
    if (L >= nM * nN) return false;
    tile_of(L, nM, nN, u.pm, u.pn); u.g = 0;
    return true;
  }
  DEVI const char* a_base(const Unit& u) const { return A + (size_t)u.pm * 256 * lda2; }
  DEVI const char* b_base(const Unit& u) const { return B + (size_t)u.pn * 256 * ldb2; }
  DEVI unsigned a_voff(int R, int C) const { return (unsigned)R * lda2 + C * 2; }
  DEVI unsigned b_voff(int R, int C) const { return (unsigned)R * ldb2 + C * 2; }
  DEVI size_t a_kstep() const { return 128; }
  DEVI size_t b_kstep() const { return 128; }
  DEVI size_t a_hstep() const { return (size_t)128 * lda2; }
  DEVI size_t b_hstep() const { return (size_t)128 * ldb2; }
};

template <bool PERM, class Sched, class Epi>
DEVI void gemm_phase(LAS unsigned char* lds, const Sched& S, const Epi& E, const int K) {
  int tid_ = tidx();
  const int tid = tid_, wid = __builtin_amdgcn_readfirstlane(tid >> 6), lane = tid & 63, wr = wid >> 2, wc = wid & 3, fr = lane & 15, fq = lane >> 4;
  const int nt = K / BK;
  unsigned voffA[2], voffB[2];
#pragma unroll
  for (int i = 0; i < 2; ++i) {
    int R, C;
    stage_rc(tid * 16 + i * 8192, R, C);
    const int Rb = PERM ? ((R & ~31) + perm32(R & 31)) : R;
    voffA[i] = S.a_voff(R, C);
    voffB[i] = S.b_voff(Rb, C);
  }
  const size_t kA = S.a_kstep(), kB = S.b_kstep(), hA = S.a_hstep(), hB = S.b_hstep();
  const unsigned ldsw = (unsigned)wid * 1024u;
  const int aoff = lds_byte(wr * 64 + fr, fq * 8), boff = lds_byte(wc * 32 + fr, fq * 8);
#define PG8_SA(b, h) (((b) * 2 + (h)) * HTB)
#define PG8_SB(b, h) ((4 + (b) * 2 + (h)) * HTB)
#define PG8_STAGE(bufoff, gbase, voff) do { _Pragma("unroll") for (int _i = 0; _i < 2; ++_i) \
    __builtin_amdgcn_global_load_lds((const unsigned*)((const char*)(gbase) + (voff)[_i]), (LAS unsigned*)(lds + (bufoff) + ldsw + _i * 8192), 16, 0, 0); } while (0)
#define PG8_LDA(dst, b, h) do { _Pragma("unroll") for (int m = 0; m < 4; ++m) _Pragma("unroll") for (int k = 0; k < 2; ++k) dst[m][k] = *(const LAS bf16x8*)(lds + PG8_SA(b, h) + aoff + m * 2048 + k * 1024); } while (0)
#define PG8_LDB(dst, b, h) do { _Pragma("unroll") for (int n = 0; n < 2; ++n) _Pragma("unroll") for (int k = 0; k < 2; ++k) dst[n][k] = *(const LAS bf16x8*)(lds + PG8_SB(b, h) + boff + n * 2048 + k * 1024); } while (0)
#define PG8_MMA(ai, bj, At, Bt) do { __builtin_amdgcn_s_setprio(1); _Pragma("unroll") for (int m = 0; m < 4; ++m) _Pragma("unroll") for (int n = 0; n < 2; ++n) _Pragma("unroll") for (int k = 0; k < 2; ++k) \
    acc[ai][bj][m][n] = __builtin_amdgcn_mfma_f32_16x16x32_bf16(Bt[n][k], At[m][k], acc[ai][bj][m][n], 0, 0, 0); __builtin_amdgcn_s_setprio(0); } while (0)
#define PG8_WAIT_V(n) asm volatile("s_waitcnt vmcnt(" #n ")" ::: "memory")
#define PG8_WAIT_L(n) asm volatile("s_waitcnt lgkmcnt(" #n ")" ::: "memory")
#define PG8_BAR __builtin_amdgcn_s_barrier()
#define PG8_SCHED __builtin_amdgcn_sched_barrier(0)
  Unit cur, nxt;
  int ui = 0;
  if (!S.next(0, cur)) return;
  f32x4 acc[2][2][4][2];
#pragma unroll
  for (int a = 0; a < 2; ++a)
#pragma unroll
    for (int b = 0; b < 2; ++b)
#pragma unroll
      for (int m = 0; m < 4; ++m)
#pragma unroll
        for (int n = 0; n < 2; ++n) acc[a][b][m][n] = (f32x4){0.f, 0.f, 0.f, 0.f};
  bf16x8 At[4][2], B0[2][2], B1[2][2];
  const char* cA = S.a_base(cur);
  const char* cB = S.b_base(cur);
  PG8_STAGE(PG8_SB(0, 0), cB, voffB); PG8_STAGE(PG8_SA(0, 0), cA, voffA); PG8_STAGE(PG8_SB(0, 1), cB + hB, voffB); PG8_STAGE(PG8_SA(0, 1), cA + hA, voffA);
  if (wr == 1) PG8_BAR;
  PG8_WAIT_V(4); PG8_BAR;
  PG8_STAGE(PG8_SB(1, 0), cB + kB, voffB); PG8_STAGE(PG8_SA(1, 0), cA + kA, voffA); PG8_STAGE(PG8_SB(1, 1), cB + hB + kB, voffB);
  PG8_WAIT_V(6); PG8_BAR;
  for (;;) {
    const bool has_next = S.next(ui + 1, nxt);
    const char* nA = has_next ? S.a_base(nxt) : cA;
    const char* nB = has_next ? S.b_base(nxt) : cB;
    for (int t = 0; t < nt; t += 2) {
      const bool last = (t == nt - 2);
      const char* a1 = cA + (size_t)(t + 1) * kA;
      const char* a2 = last ? nA : cA + (size_t)(t + 2) * kA;
      const char* b2 = last ? nB : cB + (size_t)(t + 2) * kB;
      const char* a3 = a2 + kA;
      const char* b3 = b2 + kB;
      PG8_LDB(B0, 0, 0); PG8_SCHED; PG8_LDA(At, 0, 0); PG8_STAGE(PG8_SA(1, 1), a1 + hA, voffA);
      PG8_WAIT_L(8); PG8_BAR; PG8_WAIT_L(0); PG8_MMA(0, 0, At, B0); PG8_BAR; PG8_SCHED;
      PG8_LDB(B1, 0, 1); PG8_STAGE(PG8_SB(0, 0), b2, voffB);
      PG8_BAR; PG8_WAIT_L(0); PG8_MMA(0, 1, At, B1); PG8_BAR;
      PG8_LDA(At, 0, 1); PG8_STAGE(PG8_SA(0, 0), a2, voffA);
      PG8_BAR; PG8_WAIT_L(0); PG8_MMA(1, 0, At, B0); PG8_BAR; PG8_SCHED;
      PG8_STAGE(PG8_SB(0, 1), b2 + hB, voffB);
      PG8_WAIT_V(6); PG8_BAR; PG8_MMA(1, 1, At, B1); PG8_BAR;
      PG8_LDB(B0, 1, 0); PG8_SCHED; PG8_LDA(At, 1, 0); PG8_STAGE(PG8_SA(0, 1), a2 + hA, voffA);
      PG8_WAIT_L(8); PG8_BAR; PG8_WAIT_L(0); PG8_MMA(0, 0, At, B0); PG8_BAR; PG8_SCHED;
      PG8_LDB(B1, 1, 1); PG8_STAGE(PG8_SB(1, 0), b3, voffB);
      PG8_BAR; PG8_WAIT_L(0); PG8_MMA(0, 1, At, B1); PG8_BAR;
      PG8_LDA(At, 1, 1); PG8_STAGE(PG8_SA(1, 0), a3, voffA);
      PG8_BAR; PG8_WAIT_L(0); PG8_MMA(1, 0, At, B0); PG8_BAR; PG8_SCHED;
      PG8_STAGE(PG8_SB(1, 1), b3 + hB, voffB);
      PG8_WAIT_V(6); PG8_BAR; PG8_MMA(1, 1, At, B1); PG8_BAR;
    }
    { const int l2 = tidx() & 63; E(acc, cur, wr, wc, l2 & 15, l2 >> 4); }
    if (!has_next) break;
    bool keep = false;
    if constexpr (Epi::CHAIN) keep = E.keep(cur);
    if (!keep)
#pragma unroll
    for (int a = 0; a < 2; ++a)
#pragma unroll
      for (int b = 0; b < 2; ++b)
#pragma unroll
        for (int m = 0; m < 4; ++m)
#pragma unroll
          for (int n = 0; n < 2; ++n) acc[a][b][m][n] = (f32x4){0.f, 0.f, 0.f, 0.f};
    cur = nxt; cA = nA; cB = nB; ++ui;
  }
  PG8_WAIT_V(0);
  if (wr == 0) PG8_BAR;
  PG8_BAR;
#undef PG8_SA
#undef PG8_SB
#undef PG8_STAGE
#undef PG8_LDA
#undef PG8_LDB
#undef PG8_MMA
#undef PG8_WAIT_V
#undef PG8_WAIT_L
#undef PG8_BAR
#undef PG8_SCHED
}
}
typedef f32x4 Acc8[2][2][4][2];
typedef unsigned u32x4 __attribute__((ext_vector_type(4)));
DEVI float lo16(unsigned v) { return __uint_as_float(v << 16); }
DEVI float hi16(unsigned v) { return __uint_as_float(v & 0xffff0000u); }

template <class AF, class BF>
DEVI void mma_loop(f32x4 (&acc)[4][4], int K, AF af, BF bf) {
  for (int k0 = 0; k0 < K; k0 += 32) {
    bf16x8 a[4], b[4];
#pragma unroll
    for (int i = 0; i < 4; ++i) a[i] = af(i, k0);
#pragma unroll
    for (int i = 0; i < 4; ++i) b[i] = bf(i, k0);
#pragma unroll
    for (int i = 0; i < 4; ++i)
#pragma unroll
      for (int j = 0; j < 4; ++j) acc[i][j] = mfma(a[i], b[j], acc[i][j]);
  }
}
DEVI void zero_acc(f32x4 (&acc)[4][4]) {
#pragma unroll
  for (int i = 0; i < 4; ++i)
#pragma unroll
    for (int j = 0; j < 4; ++j) acc[i][j] = f32x4{0.f, 0.f, 0.f, 0.f};
}

DEVI void tconv(const float* src, u16* dst, int nb, int K, int N, int bid, int nblk, float (*tile)[65]) {
  int tx = tidx() & 63, ty = tidx() >> 6;
  int tk = K / 64, tn = N / 64, nt = nb * tk * tn;
  for (int t = bid; t < nt; t += nblk) {
    int mb = t / (tk * tn), r = t % (tk * tn), k0 = (r / tn) * 64, n0 = (r % tn) * 64;
#pragma unroll
    for (int i = 0; i < 8; ++i) tile[ty + 8 * i][tx] = src[((size_t)mb * K + k0 + ty + 8 * i) * N + n0 + tx];
    __syncthreads();
#pragma unroll
    for (int i = 0; i < 8; ++i) dst[((size_t)mb * N + n0 + ty + 8 * i) * K + k0 + tx] = f2bf(tile[tx][ty + 8 * i]);
    __syncthreads();
  }
}

DEVI void ph_wprep(KP P, int bid, int nblk, float (*tile)[65]) {
  tconv(P->w_in, P->wt_in, 2, 1024, 9216, bid, nblk, tile);
  tconv(P->w_branch, P->wt_br, 8, 512, 1024, bid, nblk, tile);
  tconv(P->w_out, P->wt_out, 2, 1024, 1024, bid, nblk, tile);
  tconv(P->ple_gate, P->wt_pg, 2, 1024, 1024, bid, nblk, tile);
  tconv(P->ple_proj, P->wt_pp, 2, 256, 1024, bid, nblk, tile);
  tconv(P->glu_w, P->wt_glu, 2, 512, 512, bid, nblk, tile);
  tconv(P->pool_w, P->wt_pool, 8, 128, 128, bid, nblk, tile);
  tconv(P->w_r, P->wt_lr, 32, 64, 64, bid, nblk, tile);
  tconv(P->w_i, P->wt_li, 32, 64, 64, bid, nblk, tile);
}

DEVI void ph_rmsnorm(KP P, int layer, int bid, int nblk) {
  int lane = tidx() & 63, wave = tidx() >> 6;
  const float* xin = layer == 0 ? P->x : P->out;
  const float4* g4 = reinterpret_cast<const float4*>(P->norm_scale + layer * 1024);
  const int nw = nblk * 8;
  for (int t0 = bid * 8 + wave; t0 < T; t0 += nw * 4) {
    float4 v[4][4];
#pragma unroll
    for (int k = 0; k < 4; ++k) {
      const int t = t0 + k * nw;
      if (t < T) {
        const float4* x4 = reinterpret_cast<const float4*>(xin + (size_t)t * 1024);
#pragma unroll
        for (int i = 0; i < 4; ++i) v[k][i] = x4[lane + 64 * i];
      }
    }
#pragma unroll
    for (int k = 0; k < 4; ++k) {
      const int t = t0 + k * nw;
      if (t < T) {
        float ss = 0.f;
#pragma unroll
        for (int i = 0; i < 4; ++i) ss += v[k][i].x * v[k][i].x + v[k][i].y * v[k][i].y + v[k][i].z * v[k][i].z + v[k][i].w * v[k][i].w;
#pragma unroll
        for (int o = 32; o >= 1; o >>= 1) ss += __shfl_xor(ss, o);
        float rinv = rsqrtf(ss * (1.f / 1024.f) + 1e-6f);
#pragma unroll
        for (int i = 0; i < 4; ++i) {
          float4 g = g4[lane + 64 * i];
          uint2 o;
          o.x = pk2(v[k][i].x * rinv * g.x, v[k][i].y * rinv * g.y);
          o.y = pk2(v[k][i].z * rinv * g.z, v[k][i].w * rinv * g.w);
          *reinterpret_cast<uint2*>(P->hn + (size_t)t * 1024 + (lane + 64 * i) * 4) = o;
        }
      }
    }
  }
}

struct CP { float lr, li, dt, fr, fi; };
DEVI void sincos_rev(float x, float& sn, float& cs) {
  float rev = x * 0.15915494309189535f;
  rev -= rintf(rev);
  sn = __builtin_amdgcn_sinf(rev);
  cs = __builtin_amdgcn_cosf(rev);
}
DEVI CP s5p(KP P, int layer, int d, int g, int p) {
  int i1 = (layer * 2 + d) * 32 + g;
  CP c;
  c.lr = fminf(P->a_re[i1 * 64 + p], -1e-4f);
  c.li = P->a_im[i1 * 64 + p];
  c.dt = expf(P->log_dt[i1]);
  float mag = expf(c.lr * c.dt), sn = sinf(c.li * c.dt), cs = cosf(c.li * c.dt);
  float abr = mag * cs, abi = mag * sn, nr = abr - 1.f, den = c.lr * c.lr + c.li * c.li;
  c.fr = (nr * c.lr + abi * c.li) / den;
  c.fi = (abi * c.lr - nr * c.li) / den;
  return c;
}
DEVI void cpow(const CP& c, float e, float& pr, float& pi) {
  float m = expf(e * c.lr * c.dt), sn, cs;
  sincos_rev(e * c.li * c.dt, sn, cs);
  pr = m * cs;
  pi = m * sn;
}

DEVI void ph_s5pre1(KP P, int layer, int bid, int nblk, LAS unsigned char* lds) {
  int gtid = bid * NT + tidx(), gstride = nblk * NT;
  LAS float* cps = (LAS float*)lds;
  for (int idx = gtid; idx < 32 * 2 * 32 * 16; idx += gstride) {
    int co = idx & 15, tau = (idx >> 4) & 31, d = (idx >> 9) & 1, g = idx >> 10;
    int i1 = (layer * 2 + d) * 32 + g;
    __syncthreads();
    if (tidx() < 64) {
      CP c0 = s5p(P, layer, d, g, tidx());
      LAS float* o = cps + tidx() * 5;
      o[0] = c0.lr; o[1] = c0.li; o[2] = c0.dt; o[3] = c0.fr; o[4] = c0.fi;
    }
    __syncthreads();
    float acc[16];
#pragma unroll
    for (int i = 0; i < 16; ++i) acc[i] = 0.f;
    for (int p = 0; p < 64; ++p) {
      CP c;
      c.lr = cps[p * 5]; c.li = cps[p * 5 + 1]; c.dt = cps[p * 5 + 2]; c.fr = cps[p * 5 + 3]; c.fi = cps[p * 5 + 4];
      float pr, pi;
      cpow(c, (float)tau, pr, pi);
      float cr = P->sc_re[((size_t)i1 * 16 + co) * 64 + p], ci = P->sc_im[((size_t)i1 * 16 + co) * 64 + p];
      float g1r = cr * pr - ci * pi, g1i = cr * pi + ci * pr;
      float gr = g1r * c.fr - g1i * c.fi, gi = g1r * c.fi + g1i * c.fr;
      const float* br = P->sb_re + ((size_t)i1 * 64 + p) * 16;
      const float* bi = P->sb_im + ((size_t)i1 * 64 + p) * 16;
#pragma unroll
      for (int i = 0; i < 16; ++i) acc[i] += gr * br[i] - gi * bi[i];
    }
    float* o = P->ktab + (size_t)idx * 16;
#pragma unroll
    for (int i = 0; i < 16; ++i) o[i] = acc[i];
  }
  for (int idx = gtid; idx < 32 * 2 * 64 * 32; idx += gstride) {
    int i = idx & 31, p = (idx >> 5) & 63, d = (idx >> 11) & 1, g = idx >> 12;
    int i1 = (layer * 2 + d) * 32 + g;
    CP c = s5p(P, layer, d, g, p);
    float pr, pi;
    cpow(c, d == 0 ? (float)(31 - i) : (float)i, pr, pi);
    float qr = pr * c.fr - pi * c.fi, qi = pr * c.fi + pi * c.fr;
    const float* br = P->sb_re + ((size_t)i1 * 64 + p) * 16;
    const float* bi = P->sb_im + ((size_t)i1 * 64 + p) * 16;
    u16* ore = P->w1 + ((size_t)g * 256 + d * 128 + p) * 512 + i * 16;
    u16* oim = ore + (size_t)64 * 512;
#pragma unroll
    for (int ci = 0; ci < 16; ++ci) {
      ore[ci] = f2bf(qr * br[ci] - qi * bi[ci]);
      oim[ci] = f2bf(qr * bi[ci] + qi * br[ci]);
    }
  }
  for (int idx = gtid; idx < 32 * 2 * 32 * 64; idx += gstride) {
    int p = idx & 63, j = (idx >> 6) & 31, d = (idx >> 11) & 1, g = idx >> 12;
    int i1 = (layer * 2 + d) * 32 + g;
    CP c = s5p(P, layer, d, g, p);
    float pr, pi;
    cpow(c, d == 0 ? (float)(j + 1) : (float)(32 - j), pr, pi);
    for (int co = 0; co < 16; ++co) {
      float cr = P->sc_re[((size_t)i1 * 16 + co) * 64 + p], ci = P->sc_im[((size_t)i1 * 16 + co) * 64 + p];
      float gr = cr * pr - ci * pi, gi = cr * pi + ci * pr;
      u16* o = P->bg2 + ((size_t)g * 512 + j * 16 + co) * 768 + 512 + d * 128 + p;
      o[0] = f2bf(gr);
      o[64] = f2bf(-gi);
    }
  }
}
DEVI void ph_s5pre2(KP P, int bid, int nblk) {
  int gtid = bid * NT + tidx(), gstride = nblk * NT;
  for (int idx = gtid; idx < 32 * 32 * 16 * 32; idx += gstride) {
    int i = idx & 31, co = (idx >> 5) & 15, j = (idx >> 9) & 31, g = idx >> 14;
    float v[16];
#pragma unroll
    for (int ci = 0; ci < 16; ++ci) v[ci] = 0.f;
    if (i <= j) {
      const float* k = P->ktab + ((((size_t)g * 2 + 0) * 32 + (j - i)) * 16 + co) * 16;
#pragma unroll
      for (int ci = 0; ci < 16; ++ci) v[ci] += k[ci];
    }
    if (i >= j) {
      const float* k = P->ktab + ((((size_t)g * 2 + 1) * 32 + (i - j)) * 16 + co) * 16;
#pragma unroll
      for (int ci = 0; ci < 16; ++ci) v[ci] += k[ci];
    }
    u16* o = P->bg2 + ((size_t)g * 512 + j * 16 + co) * 768 + i * 16;
#pragma unroll
    for (int ci = 0; ci < 16; ++ci) o[ci] = f2bf(v[ci]);
  }
}

struct EpiZ {
  static constexpr bool CHAIN = false;
  u16* O; unsigned ldo;
  DEVI void operator()(const Acc8& acc, const pg8::Unit& u, int wr, int wc, int fr, int fq) const {
    const int row0 = u.pm * 256 + wr * 64 + fr, col0 = u.pn * 256 + wc * 32 + 8 * fq;
#pragma unroll
    for (int ai = 0; ai < 2; ++ai)
#pragma unroll
      for (int m = 0; m < 4; ++m) {
        u16* rowp = O + (size_t)(row0 + ai * 128 + m * 16) * ldo + col0;
#pragma unroll
        for (int bj = 0; bj < 2; ++bj) {
          f32x4 v0 = acc[ai][bj][m][0], v1 = acc[ai][bj][m][1];
          u32x4 o = {pk2(v0[0], v0[1]), pk2(v0[2], v0[3]), pk2(v1[0], v1[1]), pk2(v1[2], v1[3])};
          *(u32x4*)(rowp + bj * 128) = o;
        }
      }
  }
};
struct EpiZ1 {
  static constexpr bool CHAIN = false;
  u16* z; u16* ub;
  DEVI void operator()(const Acc8& acc, const pg8::Unit& u, int wr, int wc, int fr, int fq) const {
    const int row0 = u.pm * 256 + wr * 64 + fr, cl0 = wc * 32 + 8 * fq;
    const bool cx = (u.pn == 12 || u.pn == 13);
    const int zc = u.pn * 256 - (u.pn >= 14 ? 512 : 0);
#pragma unroll
    for (int ai = 0; ai < 2; ++ai)
#pragma unroll
      for (int m = 0; m < 4; ++m) {
        const unsigned r = row0 + ai * 128 + m * 16;
#pragma unroll
        for (int bj = 0; bj < 2; ++bj) {
          f32x4 v0 = acc[ai][bj][m][0], v1 = acc[ai][bj][m][1];
          u32x4 o = {pk2(v0[0], v0[1]), pk2(v0[2], v0[3]), pk2(v1[0], v1[1]), pk2(v1[2], v1[3])};
          const int cl = cl0 + bj * 128;
          if (cx) {
            const int c = (u.pn - 12) * 256 + cl;
            *(u32x4*)(ub + (((unsigned)(c >> 4) * T + r) * 16u + (c & 15))) = o;
          } else {
            *(u32x4*)(z + (r * NZ + zc + cl)) = o;
          }
        }
      }
  }
};
DEVI void ph_gemm1(KP P, int layer, int bid, int nblk, LAS unsigned char* lds) {
  pg8::SchedStd S{(const char*)P->hn, (const char*)(P->wt_in + (size_t)layer * 9216 * 1024), 2048u, 2048u, 128, 20, bid, nblk};
  EpiZ1 E{P->z, P->ub};
  pg8::gemm_phase<true>(lds, S, E, 1024);
}

constexpr int PL_XS = 272;
constexpr int PL_POFF = 144 * PL_XS;
DEVI void ph_pool(KP P, int layer, int bid, int nblk, LAS unsigned char* lds) {
  const int tid = tidx(), lane = tid & 63, wave = tid >> 6, l15 = lane & 15, q4 = lane >> 4;
  const bool skew = (nblk == 256);
  const int nmine = skew ? (bid < 128 ? 2 : 6) : (1024 - bid + nblk - 1) / nblk;
  for (int k = 0; k < nmine; ++k) {
    const int it = skew ? (bid < 128 ? 768 + bid + 128 * k : (bid - 128) + 128 * k) : bid + k * nblk;
    const int tm = it >> 2, g = it & 3;
    const int win = 2 << g, half = win >> 1;
    const int t0 = tm * 128, s0 = t0 & 4095;
    const unsigned tbase = (unsigned)(t0 - s0);
    __syncthreads();
    for (int idx = tid; idx < 144 * 16; idx += NT) {
      const int r = idx >> 4, c = idx & 15, sq = s0 - 8 + r;
      u32x4_t v = {0u, 0u, 0u, 0u};
      if (sq >= 0 && sq < 4096) v = *(const u32x4_t*)(P->z + ((tbase + sq) * NZ + ZD_X + g * 128 + c * 8));
      *(LAS u32x4_t*)(lds + r * PL_XS + c * 16) = v;
    }
    __syncthreads();
    {
      const int c = tid & 15, strip = tid >> 4;
      float acc[8];
#pragma unroll
      for (int e = 0; e < 8; ++e) acc[e] = 0.f;
      const int j0 = strip * 4;
      const LAS unsigned char* xb = lds + c * 16;
      for (int w = 0; w < win; ++w) {
        const u32x4_t v = *(const LAS u32x4_t*)(xb + (j0 + 8 - half + w) * PL_XS);
#pragma unroll
        for (int e = 0; e < 4; ++e) { acc[2 * e] += lo16(v[e]); acc[2 * e + 1] += hi16(v[e]); }
      }
#pragma unroll
      for (int j = 0; j < 4; ++j) {
        const int sq = s0 + j0 + j;
        const int lo = max(sq - half, 0), hi = min(sq - half + win, 4096);
        const float ic = __builtin_amdgcn_rcpf((float)(hi - lo));
        const u32x4_t self = *(const LAS u32x4_t*)(xb + (j0 + j + 8) * PL_XS);
        float o[8];
#pragma unroll
        for (int e = 0; e < 4; ++e) { o[2 * e] = acc[2 * e] * ic - lo16(self[e]); o[2 * e + 1] = acc[2 * e + 1] * ic - hi16(self[e]); }
        *(LAS u32x4_t*)(lds + PL_POFF + (j0 + j) * PL_XS + c * 16) = (u32x4_t){pk2(o[0], o[1]), pk2(o[2], o[3]), pk2(o[4], o[5]), pk2(o[6], o[7])};
        if (j < 3) {
          const u32x4_t vin = *(const LAS u32x4_t*)(xb + (j0 + j + 8 - half + win) * PL_XS);
          const u32x4_t vout = *(const LAS u32x4_t*)(xb + (j0 + j + 8 - half) * PL_XS);
#pragma unroll
          for (int e = 0; e < 4; ++e) { acc[2 * e] += lo16(vin[e]) - lo16(vout[e]); acc[2 * e + 1] += hi16(vin[e]) - hi16(vout[e]); }
        }
      }
    }
    __syncthreads();
    {
      const int r0 = (wave >> 1) * 32, n0 = (wave & 1) * 64;
      const u16* bp = P->wt_pool + ((size_t)(layer * 4 + g) * 128 + n0 + l15) * 128 + q4 * 8;
      f32x4 acc[2][4];
#pragma unroll
      for (int i = 0; i < 2; ++i)
#pragma unroll
        for (int j = 0; j < 4; ++j) acc[i][j] = f32x4{0.f, 0.f, 0.f, 0.f};
#pragma unroll
      for (int k0 = 0; k0 < 128; k0 += 32) {
        bf16x8 a[2], bfr[4];
#pragma unroll
        for (int i = 0; i < 2; ++i) a[i] = *(const LAS bf16x8*)(lds + PL_POFF + (r0 + i * 16 + l15) * PL_XS + (k0 + q4 * 8) * 2);
#pragma unroll
        for (int j = 0; j < 4; ++j) bfr[j] = ld8(bp + (size_t)j * 16 * 128 + k0);
#pragma unroll
        for (int i = 0; i < 2; ++i)
#pragma unroll
          for (int j = 0; j < 4; ++j) acc[i][j] = mfma(a[i], bfr[j], acc[i][j]);
      }
#pragma unroll
      for (int i = 0; i < 2; ++i)
#pragma unroll
        for (int j = 0; j < 4; ++j) {
          const int ch = g * 128 + n0 + j * 16 + l15;
          const float sc = P->pool_scale[layer * 512 + ch];
#pragma unroll
          for (int e = 0; e < 4; ++e) {
            const unsigned t = t0 + r0 + i * 16 + q4 * 4 + e;
            u16* zp = P->z + (t * NZ + ZD_G + ch);
            *zp = f2bf(acc[i][j][e] * sc * silu(bf2f(*zp)));
          }
        }
    }
  }
  __syncthreads();
}

template <bool FINAL>
DEVI void lru_unit(KP P, int layer, int u, int lane) {
  asm volatile("" : "+v"(lane));
  int l15 = lane & 15, q4 = lane >> 4;
  const float* cw = P->conv_w + layer * 4 * 512;
  const float* cb = P->conv_b + layer * 512;
  int b = u >> 9, c = (u >> 3) & 63, n = u & 7;
  int s0 = c * 64;
  unsigned tb = (unsigned)b * 4096u;
  bf16x8 xa[4][2];
#pragma unroll
  for (int ks = 0; ks < 2; ++ks) {
    int ch0 = n * 64 + ks * 32 + q4 * 8;
    float wv[4][8], bb[8];
#pragma unroll
    for (int e = 0; e < 8; ++e) bb[e] = cb[ch0 + e];
#pragma unroll
    for (int j = 0; j < 4; ++j)
#pragma unroll
      for (int e = 0; e < 8; ++e) wv[j][e] = cw[j * 512 + ch0 + e];
#pragma unroll
    for (int mt = 0; mt < 4; ++mt) {
      int s = s0 + mt * 16 + l15;
      float v[8];
#pragma unroll
      for (int e = 0; e < 8; ++e) v[e] = bb[e];
#pragma unroll
      for (int j = 0; j < 4; ++j) {
        int sj = s + j - 2;
        if (sj >= 0 && sj < 4096) {
          bf16x8 r = ld8(P->z + (unsigned)((tb + sj) * NZ + ZA_X + ch0));
#pragma unroll
          for (int e = 0; e < 8; ++e) v[e] += bfs(r[e]) * wv[j][e];
        }
      }
      xa[mt][ks] = pack8(v);
    }
    __builtin_amdgcn_sched_barrier(0);
  }
#pragma unroll 1
  for (int nt = 0; nt < 4; ++nt) {
    int ch = n * 64 + nt * 16 + l15;
    f32x4 xcv[4];
    {
#pragma unroll
      for (int mt = 0; mt < 4; ++mt) xcv[mt] = f32x4{0.f, 0.f, 0.f, 0.f};
#pragma unroll
      for (int ks = 0; ks < 2; ++ks) {
        bf16x8 id;
#pragma unroll
        for (int e = 0; e < 8; ++e) id[e] = (ks * 32 + q4 * 8 + e == nt * 16 + l15) ? (short)0x3f80 : (short)0;
#pragma unroll
        for (int mt = 0; mt < 4; ++mt) xcv[mt] = mfma(xa[mt][ks], id, xcv[mt]);
      }
    }
    float hout[4][4];
    u16 gav[4][4];
#pragma unroll
    for (int mt = 0; mt < 4; ++mt)
#pragma unroll
      for (int j = 0; j < 4; ++j) {
        hout[mt][j] = 0.f;
        if (FINAL) gav[mt][j] = P->z[(unsigned)((tb + s0 + mt * 16 + q4 * 4 + j) * NZ + ZA_G + ch)];
      }
    f32x4 ar[2][4], ai[2][4];
    float brb[2], bib[2], sp[2], h_run[2], p_run[2];
    size_t ci[2];
#pragma unroll
    for (int dir = 0; dir < 2; ++dir) {
#pragma unroll
      for (int mt = 0; mt < 4; ++mt) { ar[dir][mt] = f32x4{0.f, 0.f, 0.f, 0.f}; ai[dir][mt] = f32x4{0.f, 0.f, 0.f, 0.f}; }
      size_t wo = ((size_t)((layer * 2 + dir) * 8 + n) * 64 + nt * 16 + l15) * 64 + q4 * 8;
#pragma unroll
      for (int ks = 0; ks < 2; ++ks) {
        bf16x8 br = ld8(P->wt_lr + wo + ks * 32), bi = ld8(P->wt_li + wo + ks * 32);
#pragma unroll
        for (int mt = 0; mt < 4; ++mt) {
          ar[dir][mt] = mfma(xa[mt][ks], br, ar[dir][mt]);
          ai[dir][mt] = mfma(xa[mt][ks], bi, ai[dir][mt]);
        }
      }
      int pi = (layer * 2 + dir) * 512 + ch;
      brb[dir] = P->b_r[pi] * -1.4426950408889634f;
      bib[dir] = P->b_i[pi] * -1.4426950408889634f;
      sp[dir] = __logf(1.f + __expf(-P->lam[pi])) * (-8.f * 1.4426950408889634f);
      ci[dir] = (((size_t)b * 64 + c) * 2 + dir) * 512 + ch;
      h_run[dir] = FINAL ? P->lcar[ci[dir]] : 0.f;
      p_run[dir] = 1.f;
    }
#pragma unroll
    for (int mi = 0; mi < 4; ++mi) {
#pragma unroll
      for (int dir = 0; dir < 2; ++dir) {
        const int mt = dir == 0 ? mi : 3 - mi;
        float av[4], bv[4];
#pragma unroll
        for (int j = 0; j < 4; ++j) {
          float r = __builtin_amdgcn_rcpf(1.f + __builtin_amdgcn_exp2f(__builtin_fmaf(ar[dir][mt][j], -1.4426950408889634f, brb[dir])));
          float gi = __builtin_amdgcn_rcpf(1.f + __builtin_amdgcn_exp2f(__builtin_fmaf(ai[dir][mt][j], -1.4426950408889634f, bib[dir])));
          av[j] = __builtin_amdgcn_exp2f(r * sp[dir]);
          bv[j] = __builtin_amdgcn_sqrtf(__builtin_fmaf(-av[j], av[j], 1.f)) * (gi * xcv[mt][j]);
        }
        float Pl = av[0] * av[1] * av[2] * av[3], Hl;
        if (dir == 0) Hl = ((bv[0] * av[1] + bv[1]) * av[2] + bv[2]) * av[3] + bv[3];
        else Hl = ((bv[3] * av[2] + bv[2]) * av[1] + bv[1]) * av[0] + bv[0];
        float hq = h_run[dir];
#pragma unroll
        for (int qi = 0; qi < 3; ++qi) {
          int qq = dir == 0 ? qi : 3 - qi;
          float Pq = __shfl(Pl, l15 + 16 * qq), Hq = __shfl(Hl, l15 + 16 * qq);
          bool use = dir == 0 ? (qq < q4) : (qq > q4);
          if (use) hq = Pq * hq + Hq;
        }
        if (FINAL) {
          float h = hq;
#pragma unroll
          for (int ji = 0; ji < 4; ++ji) {
            int j = dir == 0 ? ji : 3 - ji;
            h = av[j] * h + bv[j];
            hout[mt][j] += h;
          }
        }
        float full = Pl * hq + Hl;
        h_run[dir] = __shfl(full, l15 + (dir == 0 ? 48 : 0));
        if (!FINAL) {
          float pt = Pl * __shfl_xor(Pl, 16);
          pt *= __shfl_xor(pt, 32);
          p_run[dir] *= pt;
        }
      }
    }
    if (!FINAL && q4 == 0) {
#pragma unroll
      for (int dir = 0; dir < 2; ++dir) {
        P->lagg[ci[dir] * 2] = p_run[dir];
        P->lagg[ci[dir] * 2 + 1] = h_run[dir];
      }
    }
    if (FINAL) {
#pragma unroll
      for (int mt = 0; mt < 4; ++mt)
#pragma unroll
        for (int j = 0; j < 4; ++j) {
          u16* zp = P->z + (unsigned)((tb + s0 + mt * 16 + q4 * 4 + j) * NZ + ZA_G + ch);
          *zp = f2bf(hout[mt][j] * silu(bf2f(gav[mt][j])));
        }
    }
  }
}

DEVI void ph_lru_carry(KP P, int bid, int nblk) {
  for (int idx = bid * NT + tidx(); idx < 8 * 2 * 512; idx += nblk * NT) {
    int ch = idx & 511, dir = (idx >> 9) & 1, b = idx >> 10;
    float h = 0.f;
    for (int c0 = 0; c0 < 64; c0 += 16) {
      float2 ag[16];
#pragma unroll
      for (int k = 0; k < 16; ++k) {
        const int c = dir == 0 ? c0 + k : 63 - (c0 + k);
        const size_t o = (((size_t)b * 64 + c) * 2 + dir) * 512 + ch;
        ag[k] = *(const float2*)(P->lagg + o * 2);
      }
#pragma unroll
      for (int k = 0; k < 16; ++k) {
        const int c = dir == 0 ? c0 + k : 63 - (c0 + k);
        const size_t o = (((size_t)b * 64 + c) * 2 + dir) * 512 + ch;
        P->lcar[o] = h;
        h = ag[k].x * h + ag[k].y;
      }
    }
  }
}

typedef __attribute__((ext_vector_type(2))) __bf16 bf2_t;
DEVI float dot2sq(unsigned x, float c) {
  bf2_t v = __builtin_bit_cast(bf2_t, x);
  return __builtin_amdgcn_fdot2_f32_bf16(v, v, c, false);
}
constexpr int NA_RS = 144;
constexpr int NA_VOFF = 16384;
DEVI void na_unit(KP P, int layer, int u, int lane, const LAS float* rpl, LAS unsigned char* vb) {
  asm volatile("" : "+v"(lane));
  const int l15 = lane & 15, q4 = lane >> 4;
  const int h = u & 7, jb = (u >> 3) & 3, r = (u >> 5) & 63, b = u >> 11;
  const int rs = min(max(r - 4, 0), 56);
  const int bs = min(max(16 * jb - 8, 0), 32);
  const unsigned tb = (unsigned)b * 4096u;
  const float LOG2E = 1.4426950408889634f;
  bf16x8 qf[2];
  {
    const unsigned tq = tb + r * 64 + jb * 16 + l15;
    u32x4_t raw[2];
    float ss = 0.f;
#pragma unroll
    for (int ks = 0; ks < 2; ++ks) {
      raw[ks] = *(const u32x4_t*)(P->z + (tq * NZ + ZQ + h * 64 + ks * 32 + q4 * 8));
#pragma unroll
      for (int e = 0; e < 4; ++e) ss = dot2sq(raw[ks][e], ss);
    }
    ss += __shfl_xor(ss, 16);
    ss += __shfl_xor(ss, 32);
    const float rq = rsqrtf(ss * (1.f / 64.f) + 1e-6f) * (0.125f * LOG2E);
#pragma unroll
    for (int ks = 0; ks < 2; ++ks) {
      const float* qg = P->q_gain + layer * 64 + ks * 32 + q4 * 8;
      const float* kg = P->k_gain + layer * 64 + ks * 32 + q4 * 8;
      float v[8];
#pragma unroll
      for (int e = 0; e < 4; ++e) {
        v[2 * e] = lo16(raw[ks][e]) * rq * qg[2 * e] * kg[2 * e];
        v[2 * e + 1] = hi16(raw[ks][e]) * rq * qg[2 * e + 1] * kg[2 * e + 1];
      }
      qf[ks] = pack8(v);
    }
  }
  u16 gv[4][4];
#pragma unroll
  for (int j = 0; j < 4; ++j)
#pragma unroll
    for (int dt = 0; dt < 4; ++dt) gv[j][dt] = P->z[(tb + r * 64 + jb * 16 + q4 * 4 + j) * NZ + ZB_G + h * 64 + dt * 16 + l15];
  const int qcol = jb * 16 + l15;
  const int ws = min(max(qcol - 8, 0), 48);
  unsigned vmask = 0;
  int dcx[2][4];
#pragma unroll
  for (int t = 0; t < 2; ++t)
#pragma unroll
    for (int j = 0; j < 4; ++j) {
      const int kcol = bs + 8 * q4 + 4 * t + j;
      if (kcol >= ws && kcol < ws + 16) vmask |= 1u << (t * 4 + j);
      dcx[t][j] = min(max(kcol - qcol, -15), 15) + 15;
    }
  const LAS float* rp = rpl + h * 465 + (rs - r + 7) * 31;
  const int kxa = 8 * (l15 >> 2) + (l15 & 3);
  const unsigned kbase = (tb + rs * 64 + bs + kxa) * NZ + ZK + h * 64 + q4 * 8;
  f32x4 sc[16];
  u32x4_t kq[16][2];
#pragma unroll
  for (int i = 0; i < 16; ++i) {
    const unsigned ko = kbase + (unsigned)((i >> 1) * 64 + 4 * (i & 1)) * NZ;
    kq[i][0] = *(const u32x4_t*)(P->z + ko);
    kq[i][1] = *(const u32x4_t*)(P->z + ko + 32);
  }
#pragma unroll
  for (int gi = 0; gi < 2; ++gi) {
    float rkv[8];
#pragma unroll
    for (int i = 0; i < 8; ++i) {
      const int nt = gi * 8 + i;
      float ss = 0.f;
#pragma unroll
      for (int e = 0; e < 4; ++e) { ss = dot2sq(kq[nt][0][e], ss); ss = dot2sq(kq[nt][1][e], ss); }
      ss += __shfl_xor(ss, 16);
      ss += __shfl_xor(ss, 32);
      rkv[i] = rsqrtf(ss * (1.f / 64.f) + 1e-6f);
      f32x4 a = f32x4{0.f, 0.f, 0.f, 0.f};
      a = mfma(__builtin_bit_cast(bf16x8, kq[nt][0]), qf[0], a);
      a = mfma(__builtin_bit_cast(bf16x8, kq[nt][1]), qf[1], a);
      sc[nt] = a;
    }
#pragma unroll
    for (int i = 0; i < 8; ++i) {
      const int nt = gi * 8 + i, kri = nt >> 1, t = nt & 1;
#pragma unroll
      for (int j = 0; j < 4; ++j) {
        const float rkj = __shfl(rkv[i], (lane & 48) + 4 * q4 + j);
        const float bias = rp[kri * 31 + dcx[t][j]];
        sc[nt][j] = ((vmask >> (t * 4 + j)) & 1u) ? sc[nt][j] * rkj + bias : -1e30f;
      }
    }
    __builtin_amdgcn_sched_barrier(0);
  }
  const unsigned vg0 = (tb + rs * 64 + bs + (lane >> 3)) * NZ + ZV + h * 64 + (lane & 7) * 8;
  u32x4_t vreg[8][4];
#pragma unroll
  for (int s8 = 0; s8 < 4; ++s8)
#pragma unroll
    for (int i = 0; i < 4; ++i) vreg[s8][i] = *(const u32x4_t*)(P->z + vg0 + (unsigned)(s8 * 64 + 8 * i) * NZ);
  float mx = -1e30f;
#pragma unroll
  for (int nt = 0; nt < 16; ++nt)
#pragma unroll
    for (int j = 0; j < 4; ++j) mx = fmaxf(mx, sc[nt][j]);
  mx = fmaxf(mx, __shfl_xor(mx, 16));
  mx = fmaxf(mx, __shfl_xor(mx, 32));
  float sum = 0.f;
#pragma unroll
  for (int nt = 0; nt < 16; ++nt)
#pragma unroll
    for (int j = 0; j < 4; ++j) {
      const float pv = __builtin_amdgcn_exp2f(sc[nt][j] - mx);
      sc[nt][j] = pv;
      sum += pv;
    }
  sum += __shfl_xor(sum, 16);
  sum += __shfl_xor(sum, 32);
  u32x4_t pfu[8];
#pragma unroll
  for (int s8 = 0; s8 < 8; ++s8)
    pfu[s8] = (u32x4_t){pk2(sc[2 * s8][0], sc[2 * s8][1]), pk2(sc[2 * s8][2], sc[2 * s8][3]), pk2(sc[2 * s8 + 1][0], sc[2 * s8 + 1][1]),
                        pk2(sc[2 * s8 + 1][2], sc[2 * s8 + 1][3])};
  __builtin_amdgcn_sched_barrier(0);
#pragma unroll
  for (int s8 = 4; s8 < 8; ++s8)
#pragma unroll
    for (int i = 0; i < 4; ++i) vreg[s8][i] = *(const u32x4_t*)(P->z + vg0 + (unsigned)(s8 * 64 + 8 * i) * NZ);
  f32x4 oacc[4];
#pragma unroll
  for (int dt = 0; dt < 4; ++dt) oacc[dt] = f32x4{0.f, 0.f, 0.f, 0.f};
  LAS unsigned char* vw = vb + (lane >> 3) * NA_RS + (lane & 7) * 16;
  const unsigned vr = (unsigned)(size_t)(vb + (8 * q4 + (l15 >> 2)) * NA_RS + 8 * (lane & 3));
#pragma unroll
  for (int s8 = 0; s8 < 8; ++s8) {
#pragma unroll
    for (int i = 0; i < 4; ++i) *(LAS u32x4_t*)(vw + 8 * i * NA_RS) = vreg[s8][i];
    typedef unsigned u32x2_t __attribute__((ext_vector_type(2)));
    u32x2_t t0, t1, t2, t3, t4, t5, t6, t7;
    asm volatile(
        "s_waitcnt lgkmcnt(0)\n\t"
        "ds_read_b64_tr_b16 %0, %8\n\t"
        "ds_read_b64_tr_b16 %1, %8 offset:576\n\t"
        "ds_read_b64_tr_b16 %2, %8 offset:32\n\t"
        "ds_read_b64_tr_b16 %3, %8 offset:608\n\t"
        "ds_read_b64_tr_b16 %4, %8 offset:64\n\t"
        "ds_read_b64_tr_b16 %5, %8 offset:640\n\t"
        "ds_read_b64_tr_b16 %6, %8 offset:96\n\t"
        "ds_read_b64_tr_b16 %7, %8 offset:672\n\t"
        "s_waitcnt lgkmcnt(0)"
        : "=&v"(t0), "=&v"(t1), "=&v"(t2), "=&v"(t3), "=&v"(t4), "=&v"(t5), "=&v"(t6), "=&v"(t7)
        : "v"(vr)
        : "memory");
    const bf16x8 pf = __builtin_bit_cast(bf16x8, pfu[s8]);
    oacc[0] = mfma(pf, __builtin_bit_cast(bf16x8, (u32x4_t){t0[0], t0[1], t1[0], t1[1]}), oacc[0]);
    oacc[1] = mfma(pf, __builtin_bit_cast(bf16x8, (u32x4_t){t2[0], t2[1], t3[0], t3[1]}), oacc[1]);
    oacc[2] = mfma(pf, __builtin_bit_cast(bf16x8, (u32x4_t){t4[0], t4[1], t5[0], t5[1]}), oacc[2]);
    oacc[3] = mfma(pf, __builtin_bit_cast(bf16x8, (u32x4_t){t6[0], t6[1], t7[0], t7[1]}), oacc[3]);
  }
#pragma unroll
  for (int j = 0; j < 4; ++j) {
    const float inv = __builtin_amdgcn_rcpf(__shfl(sum, q4 * 4 + j));
    const unsigned t = tb + r * 64 + jb * 16 + q4 * 4 + j;
#pragma unroll
    for (int dt = 0; dt < 4; ++dt) {
      u16* zp = P->z + (t * NZ + ZB_G + h * 64 + dt * 16 + l15);
      *zp = f2bf(oacc[dt][j] * inv * silu(bf2f(gv[j][dt])));
    }
  }
}

struct SchedS5U {
  const char* ub; const char* B; unsigned ldb2; size_t bgs;
  int nPN, nUnits, c, G;
  DEVI bool next(int i, pg8::Unit& u) const {
    const int L = i * G + c;
    if (L >= nUnits) return false;
    u.pn = L % nPN; u.pm = (L / nPN) & 3; u.g = L / (nPN * 4);
    return true;
  }
  DEVI const char* a_base(const pg8::Unit& u) const { return ub + ((size_t)u.g * 1024 + (size_t)u.pm * 256) * 1024; }
  DEVI const char* b_base(const pg8::Unit& u) const { return B + (size_t)u.g * bgs + (size_t)u.pn * 256 * ldb2; }
  DEVI unsigned a_voff(int R, int C) const { return (unsigned)R * 1024u + C * 2; }
  DEVI unsigned b_voff(int R, int C) const { return (unsigned)R * ldb2 + C * 2; }
  DEVI size_t a_kstep() const { return 128; }
  DEVI size_t b_kstep() const { return 128; }
  DEVI size_t a_hstep() const { return (size_t)128 * 1024; }
  DEVI size_t b_hstep() const { return (size_t)128 * ldb2; }
};
struct EpiE {
  static constexpr bool CHAIN = false;
  u16* O;
  DEVI void operator()(const Acc8& acc, const pg8::Unit& u, int wr, int wc, int fr, int fq) const {
    const int row0 = u.g * 1024 + u.pm * 256 + wr * 64 + fr, col0 = wc * 32 + 8 * fq;
#pragma unroll
    for (int ai = 0; ai < 2; ++ai)
#pragma unroll
      for (int m = 0; m < 4; ++m) {
        u16* rowp = O + (size_t)(row0 + ai * 128 + m * 16) * 256 + col0;
#pragma unroll
        for (int bj = 0; bj < 2; ++bj) {
          f32x4 v0 = acc[ai][bj][m][0], v1 = acc[ai][bj][m][1];
          u32x4 o = {pk2(v0[0], v0[1]), pk2(v0[2], v0[3]), pk2(v1[0], v1[1]), pk2(v1[2], v1[3])};
          *(u32x4*)(rowp + bj * 128) = o;
        }
      }
  }
};
DEVI void s5_g1(KP P, int bid, int nblk, LAS unsigned char* lds) {
  SchedS5U S{(const char*)P->ub, (const char*)P->w1, 1024u, (size_t)256 * 512 * 2, 1, 128, bid, nblk};
  EpiE E{P->ecar};
  pg8::gemm_phase<true>(lds, S, E, 512);
}

DEVI void ph_s5_carry(KP P, int layer, int bid, int nblk) {
  for (int idx = bid * NT + tidx(); idx < 8 * 32 * 2 * 64; idx += nblk * NT) {
    int p = idx & 63, d = (idx >> 6) & 1, g = (idx >> 7) & 31, b = idx >> 12;
    CP c = s5p(P, layer, d, g, p);
    float ar, ai;
    cpow(c, 32.f, ar, ai);
    float hr = 0.f, hi = 0.f;
    u16* base = P->ecar + ((size_t)g * 1024 + b * 128) * 256 + d * 128 + p;
    for (int c0 = 0; c0 < 128; c0 += 32) {
      u16 er[32], ei[32];
#pragma unroll
      for (int k = 0; k < 32; ++k) {
        const int cc = d == 0 ? c0 + k : 127 - (c0 + k);
        er[k] = base[(size_t)cc * 256];
        ei[k] = base[(size_t)cc * 256 + 64];
      }
#pragma unroll
      for (int k = 0; k < 32; ++k) {
        const int cc = d == 0 ? c0 + k : 127 - (c0 + k);
        base[(size_t)cc * 256] = f2bf(hr);
        base[(size_t)cc * 256 + 64] = f2bf(hi);
        const float nr = ar * hr - ai * hi + bf2f(er[k]), ni = ar * hi + ai * hr + bf2f(ei[k]);
        hr = nr;
        hi = ni;
      }
    }
  }
}

struct SchedS5C {
  const char* A; const char* B; int c, G;
  DEVI bool next(int i, pg8::Unit& u) const {
    const int L = i * G + c;
    if (L >= 256) return false;
    u.pn = L & 1; u.pm = (L >> 1) & 3; u.g = L >> 3;
    return true;
  }
  DEVI const char* a_base(const pg8::Unit& u) const { return A + ((size_t)u.g * 1024 + u.pm * 256) * 512; }
  DEVI const char* b_base(const pg8::Unit& u) const { return B + ((size_t)u.g * 512 + u.pn * 256) * 1536 + 1024; }
  DEVI unsigned a_voff(int R, int C) const { return (unsigned)R * 512u + C * 2; }
  DEVI unsigned b_voff(int R, int C) const { return (unsigned)R * 1536u + C * 2; }
  DEVI size_t a_kstep() const { return 128; }
  DEVI size_t b_kstep() const { return 128; }
  DEVI size_t a_hstep() const { return (size_t)128 * 512; }
  DEVI size_t b_hstep() const { return (size_t)128 * 1536; }
};
template <bool SECOND>
struct EpiYg {
  static constexpr bool CHAIN = false;
  u16* z; const u16* ub; const float* dsk;
  DEVI void operator()(const Acc8& acc, const pg8::Unit& u, int wr, int wc, int fr, int fq) const {
    const int m0 = u.pm * 256 + wr * 64 + fr, n00 = u.pn * 256 + wc * 32 + 8 * fq;
#pragma unroll
    for (int ai = 0; ai < 2; ++ai)
#pragma unroll
      for (int bj = 0; bj < 2; ++bj) {
        const int n0 = n00 + bj * 128;
        const int ch = u.g * 16 + (n0 & 15);
        f32x4 d0, d1;
        if (SECOND) { d0 = *(const f32x4*)(dsk + ch); d1 = *(const f32x4*)(dsk + ch + 4); }
#pragma unroll
        for (int mh = 0; mh < 2; ++mh) {
          u32x4 pp[2], uu[2];
          u16* yp[2];
#pragma unroll
          for (int mm = 0; mm < 2; ++mm) {
            const int m = mh * 2 + mm;
            const unsigned t = (unsigned)(m0 + ai * 128 + m * 16) * 32u + (n0 >> 4);
            yp[mm] = z + (t * NZ + ZYG + ch);
            if (SECOND) {
              pp[mm] = *(const u32x4*)yp[mm];
              uu[mm] = *(const u32x4*)(ub + (((unsigned)u.g * T + t) * 16u + (n0 & 15)));
            }
          }
#pragma unroll
          for (int mm = 0; mm < 2; ++mm) {
            const int m = mh * 2 + mm;
            f32x4 v0 = acc[ai][bj][m][0], v1 = acc[ai][bj][m][1];
            float v[8] = {v0[0], v0[1], v0[2], v0[3], v1[0], v1[1], v1[2], v1[3]};
            if (SECOND) {
              float dd[8] = {d0[0], d0[1], d0[2], d0[3], d1[0], d1[1], d1[2], d1[3]};
#pragma unroll
              for (int e = 0; e < 4; ++e) {
                v[2 * e] = gelu_t(v[2 * e] + lo16(pp[mm][e]) + dd[2 * e] * lo16(uu[mm][e]));
                v[2 * e + 1] = gelu_t(v[2 * e + 1] + hi16(pp[mm][e]) + dd[2 * e + 1] * hi16(uu[mm][e]));
              }
            }
            u32x4 o = {pk2(v[0], v[1]), pk2(v[2], v[3]), pk2(v[4], v[5]), pk2(v[6], v[7])};
            *(u32x4*)yp[mm] = o;
          }
          __builtin_amdgcn_sched_barrier(0);
        }
      }
  }
};
DEVI void s5_g2(KP P, int layer, int bid, int nblk, LAS unsigned char* lds) {
  {
    SchedS5C S{(const char*)P->ecar, (const char*)P->bg2, bid, nblk};
    EpiYg<false> E{P->z, P->ub, P->s_d + layer * 512};
    pg8::gemm_phase<true>(lds, S, E, 256);
  }
  {
    SchedS5U S{(const char*)P->ub, (const char*)P->bg2, 1536u, (size_t)512 * 768 * 2, 2, 256, bid, nblk};
    EpiYg<true> E{P->z, P->ub, P->s_d + layer * 512};
    pg8::gemm_phase<true>(lds, S, E, 512);
  }
}

struct EpiGlu {
  static constexpr bool CHAIN = false;
  u16* z; const float* gb;
  DEVI void operator()(const Acc8& acc, const pg8::Unit& u, int wr, int wc, int fr, int fq) const {
    const int row0 = u.pm * 256 + wr * 64 + fr, col0 = u.pn * 256 + wc * 32 + 8 * fq;
#pragma unroll
    for (int ai = 0; ai < 2; ++ai)
#pragma unroll
      for (int bj = 0; bj < 2; ++bj) {
        const int c = col0 + bj * 128;
        u32x4 yg[4], cg[4];
#pragma unroll
        for (int m = 0; m < 4; ++m) {
          u16* rowp = z + (unsigned)(row0 + ai * 128 + m * 16) * NZ;
          yg[m] = *(const u32x4*)(rowp + ZYG + c);
          cg[m] = *(const u32x4*)(rowp + ZC_G + c);
        }
        const f32x4 b0 = *(const f32x4*)(gb + c), b1 = *(const f32x4*)(gb + c + 4);
#pragma unroll
        for (int m = 0; m < 4; ++m) {
          u16* rowp = z + (unsigned)(row0 + ai * 128 + m * 16) * NZ;
          f32x4 v0 = acc[ai][bj][m][0] + b0, v1 = acc[ai][bj][m][1] + b1;
          float v[8] = {v0[0], v0[1], v0[2], v0[3], v1[0], v1[1], v1[2], v1[3]};
#pragma unroll
          for (int e = 0; e < 4; ++e) {
            v[2 * e] = lo16(yg[m][e]) * sigm(v[2 * e]) * silu(lo16(cg[m][e]));
            v[2 * e + 1] = hi16(yg[m][e]) * sigm(v[2 * e + 1]) * silu(hi16(cg[m][e]));
          }
          u32x4 o = {pk2(v[0], v[1]), pk2(v[2], v[3]), pk2(v[4], v[5]), pk2(v[6], v[7])};
          *(u32x4*)(rowp + ZC_G + c) = o;
        }
        __builtin_amdgcn_sched_barrier(0);
      }
  }
};
DEVI void ph_glu(KP P, int layer, int bid, int nblk, LAS unsigned char* lds) {
  pg8::SchedStd S{(const char*)(P->z + ZYG), (const char*)(P->wt_glu + (size_t)layer * 512 * 512), (unsigned)NZ * 2, 1024u, 128, 2, bid, nblk};
  EpiGlu E{P->z, P->glu_b + layer * 512};
  pg8::gemm_phase<true>(lds, S, E, 512);
}

struct SchedNB {
  const char* A; const char* B; unsigned lda2, ldb2; size_t b_nb; bool a_cols; int c, G;
  DEVI bool next(int i, pg8::Unit& u) const {
    if (i >= 8) return false;
    const int L = (i >> 2) * G + c;
    if (L >= 512) return false;
    pg8::tile_of(L, 128, 4, u.pm, u.pn); u.g = i & 3;
    return true;
  }
  DEVI const char* a_base(const pg8::Unit& u) const {
    const int gc = u.g == 0 ? ZA_G : u.g == 1 ? ZB_G : u.g == 2 ? ZC_G : ZD_G;
    return A + (a_cols ? gc * 2 : 0) + (size_t)u.pm * 256 * lda2;
  }
  DEVI const char* b_base(const pg8::Unit& u) const { return B + (size_t)u.g * b_nb + (size_t)u.pn * 256 * ldb2; }
  DEVI unsigned a_voff(int R, int C) const { return (unsigned)R * lda2 + C * 2; }
  DEVI unsigned b_voff(int R, int C) const { return (unsigned)R * ldb2 + C * 2; }
  DEVI size_t a_kstep() const { return 128; }
  DEVI size_t b_kstep() const { return 128; }
  DEVI size_t a_hstep() const { return (size_t)128 * lda2; }
  DEVI size_t b_hstep() const { return (size_t)128 * ldb2; }
};
DEVI u16* gate_row(u16* z, u16* ub, int nb, unsigned r) {
  return nb == 3 ? ub + r * 512u : z + (r * NZ + (nb == 0 ? 0 : nb == 1 ? 2048 : ZD_X));
}
struct EpiGateU8 {
  static constexpr bool CHAIN = false;
  u16* z; u16* ub;
  DEVI void operator()(const Acc8& acc, const pg8::Unit& u, int wr, int wc, int fr, int fq) const {
    const int row0 = u.pm * 256 + wr * 64 + fr, cl0 = wc * 32 + 8 * fq;
#pragma unroll
    for (int ai = 0; ai < 2; ++ai)
#pragma unroll
      for (int m = 0; m < 4; ++m) {
        const unsigned r = row0 + ai * 128 + m * 16;
        u16* gp = gate_row(z, ub, u.g, r) + u.pn * 128;
#pragma unroll
        for (int bj = 0; bj < 2; ++bj) {
          const int cl = cl0 + bj * 128;
          f32x4 v0 = acc[ai][bj][m][0], v1 = acc[ai][bj][m][1];
          uint2 o = {0u, 0u};
#pragma unroll
          for (int e = 0; e < 4; ++e) {
            o.x = __builtin_amdgcn_cvt_pk_u8_f32(fmaxf(sigm(v0[e]) * 255.f, 1.f), e, o.x);
            o.y = __builtin_amdgcn_cvt_pk_u8_f32(fmaxf(sigm(v1[e]) * 255.f, 1.f), e, o.y);
          }
          *(uint2*)(gp + (cl >> 1)) = o;
        }
      }
  }
};
struct EpiMergeChain {
  static constexpr bool CHAIN = true;
  u16* z; u16* ub;
  DEVI bool keep(const pg8::Unit& u) const { return u.g < 3; }
  DEVI void operator()(Acc8& acc, const pg8::Unit& u, int wr, int wc, int fr, int fq) const {
    const int row0 = u.pm * 256 + wr * 64 + fr, cl0 = wc * 32 + 8 * fq;
    const int nb = u.g, nbn = nb < 3 ? nb + 1 : 3;
#pragma unroll
    for (int ai = 0; ai < 2; ++ai)
#pragma unroll
      for (int bj = 0; bj < 2; ++bj) {
        const int cl = cl0 + bj * 128;
        uint2 ga[4], gb[4];
#pragma unroll
        for (int m = 0; m < 4; ++m) {
          const unsigned r = row0 + ai * 128 + m * 16;
          ga[m] = *(const uint2*)(gate_row(z, ub, nb, r) + u.pn * 128 + (cl >> 1));
          gb[m] = *(const uint2*)(gate_row(z, ub, nbn, r) + u.pn * 128 + (cl >> 1));
        }
#pragma unroll
        for (int m = 0; m < 4; ++m) {
          const unsigned r = row0 + ai * 128 + m * 16;
          float f[8];
#pragma unroll
          for (int e = 0; e < 4; ++e) {
            const float a0 = (float)((ga[m].x >> (8 * e)) & 255u), a1 = (float)((ga[m].y >> (8 * e)) & 255u);
            const float b0 = (float)((gb[m].x >> (8 * e)) & 255u), b1 = (float)((gb[m].y >> (8 * e)) & 255u);
            f[e] = nb < 3 ? a0 * __builtin_amdgcn_rcpf(b0) : a0 * (1.f / 255.f);
            f[4 + e] = nb < 3 ? a1 * __builtin_amdgcn_rcpf(b1) : a1 * (1.f / 255.f);
          }
          f32x4 v0 = acc[ai][bj][m][0], v1 = acc[ai][bj][m][1];
#pragma unroll
          for (int e = 0; e < 4; ++e) { v0[e] *= f[e]; v1[e] *= f[4 + e]; }
          acc[ai][bj][m][0] = v0;
          acc[ai][bj][m][1] = v1;
          if (nb == 3) {
            u32x4 o = {pk2(v0[0], v0[1]), pk2(v0[2], v0[3]), pk2(v1[0], v1[1]), pk2(v1[2], v1[3])};
            *(u32x4*)(z + (r * NZ + ZMRG + u.pn * 256 + cl)) = o;
          }
        }
        __builtin_amdgcn_sched_barrier(0);
      }
  }
};
DEVI void ph_merge(KP P, int layer, int bid, int nblk, LAS unsigned char* lds) {
  {
    SchedNB S{(const char*)P->hn, (const char*)(P->wt_in + ((size_t)layer * 9216 + 5120) * 1024), 2048u, 2048u, (size_t)1024 * 1024 * 2, false, bid, nblk};
    EpiGateU8 E{P->z, P->ub};
    pg8::gemm_phase<true>(lds, S, E, 1024);
  }
  {
    SchedNB S{(const char*)P->z, (const char*)(P->wt_br + (size_t)layer * 4 * 1024 * 512), (unsigned)NZ * 2, 1024u, (size_t)1024 * 512 * 2, true, bid, nblk};
    EpiMergeChain E{P->z, P->ub};
    pg8::gemm_phase<true>(lds, S, E, 512);
  }
}

struct EpiWout {
  static constexpr bool CHAIN = false;
  const float* xin; float* out; u16* hn;
  DEVI void operator()(const Acc8& acc, const pg8::Unit& u, int wr, int wc, int fr, int fq) const {
    const int row0 = u.pm * 256 + wr * 64 + fr, col0 = u.pn * 256 + wc * 32 + 4 * fq;
#pragma unroll
    for (int ai = 0; ai < 2; ++ai)
#pragma unroll
      for (int m = 0; m < 4; ++m) {
        const unsigned ro = (unsigned)(row0 + ai * 128 + m * 16) * 1024u;
        f32x4 xv[2][2];
#pragma unroll
        for (int bj = 0; bj < 2; ++bj)
#pragma unroll
          for (int n = 0; n < 2; ++n) xv[bj][n] = *(const f32x4*)(xin + (ro + col0 + bj * 128 + n * 16));
#pragma unroll
        for (int bj = 0; bj < 2; ++bj)
#pragma unroll
          for (int n = 0; n < 2; ++n) {
            const unsigned o = ro + col0 + bj * 128 + n * 16;
            f32x4 v = xv[bj][n] + acc[ai][bj][m][n];
            *(f32x4*)(out + o) = v;
            uint2 h = {pk2(v[0], v[1]), pk2(v[2], v[3])};
            *(uint2*)(hn + o) = h;
          }
        if (m & 1) __builtin_amdgcn_sched_barrier(0);
      }
  }
};
DEVI void ph_wout(KP P, int layer, int bid, int nblk, LAS unsigned char* lds) {
  pg8::SchedStd S{(const char*)(P->z + ZMRG), (const char*)(P->wt_out + (size_t)layer * 1024 * 1024), (unsigned)NZ * 2, 2048u, 128, 4, bid, nblk};
  EpiWout E{layer == 0 ? P->x : P->out, P->out, P->hn};
  pg8::gemm_phase<false>(lds, S, E, 1024);
  const float* pl = P->p + (size_t)layer * T * 256;
  const int gs = nblk * NT;
  for (int idx0 = bid * NT + tidx(); idx0 < T * 32; idx0 += gs * 4) {
    f32x4 a[4], b[4];
#pragma unroll
    for (int k = 0; k < 4; ++k) {
      const int idx = idx0 + k * gs;
      if (idx < T * 32) {
        const int t = idx >> 5, c = (idx & 31) * 8;
        a[k] = *(const f32x4*)(pl + (size_t)t * 256 + c);
        b[k] = *(const f32x4*)(pl + (size_t)t * 256 + c + 4);
      }
    }
#pragma unroll
    for (int k = 0; k < 4; ++k) {
      const int idx = idx0 + k * gs;
      if (idx < T * 32) {
        const int t = idx >> 5, c = (idx & 31) * 8;
        u32x4 o = {pk2(a[k][0], a[k][1]), pk2(a[k][2], a[k][3]), pk2(b[k][0], b[k][1]), pk2(b[k][2], b[k][3])};
        *(u32x4*)(P->z + (size_t)t * NZ + c) = o;
      }
    }
  }
}

struct EpiPle {
  static constexpr bool CHAIN = false;
  const u16* z; float* out;
  DEVI void operator()(const Acc8& acc, const pg8::Unit& u, int wr, int wc, int fr, int fq) const {
    const int row0 = u.pm * 256 + wr * 64 + fr, col0 = u.pn * 256 + wc * 32 + 8 * fq;
#pragma unroll
    for (int ai = 0; ai < 2; ++ai)
#pragma unroll
      for (int bj = 0; bj < 2; ++bj) {
        const int c = col0 + bj * 128;
        u32x4 pr[4];
        f32x4 x0[4], x1[4];
#pragma unroll
        for (int m = 0; m < 4; ++m) {
          const unsigned r = row0 + ai * 128 + m * 16;
          pr[m] = *(const u32x4*)(z + (r * NZ + ZMRG + c));
          x0[m] = *(const f32x4*)(out + (r * 1024u + c));
          x1[m] = *(const f32x4*)(out + (r * 1024u + c + 4));
        }
#pragma unroll
        for (int m = 0; m < 4; ++m) {
          const unsigned r = row0 + ai * 128 + m * 16;
          f32x4 v0 = acc[ai][bj][m][0], v1 = acc[ai][bj][m][1];
          f32x4 a = x0[m], bq = x1[m];
          a[0] += sigm(v0[0]) * lo16(pr[m][0]); a[1] += sigm(v0[1]) * hi16(pr[m][0]);
          a[2] += sigm(v0[2]) * lo16(pr[m][1]); a[3] += sigm(v0[3]) * hi16(pr[m][1]);
          bq[0] += sigm(v1[0]) * lo16(pr[m][2]); bq[1] += sigm(v1[1]) * hi16(pr[m][2]);
          bq[2] += sigm(v1[2]) * lo16(pr[m][3]); bq[3] += sigm(v1[3]) * hi16(pr[m][3]);
          *(f32x4*)(out + (r * 1024u + c)) = a;
          *(f32x4*)(out + (r * 1024u + c + 4)) = bq;
        }
        __builtin_amdgcn_sched_barrier(0);
      }
  }
};
DEVI void ph_ple(KP P, int layer, int bid, int nblk, LAS unsigned char* lds) {
  {
    pg8::SchedStd S{(const char*)P->z, (const char*)(P->wt_pp + (size_t)layer * 1024 * 256), (unsigned)NZ * 2, 512u, 128, 4, bid, nblk};
    EpiZ E{P->z + ZMRG, (unsigned)NZ};
    pg8::gemm_phase<true>(lds, S, E, 256);
  }
  {
    pg8::SchedStd S{(const char*)P->hn, (const char*)(P->wt_pg + (size_t)layer * 1024 * 1024), 2048u, 2048u, 128, 4, bid, nblk};
    EpiPle E{P->z, P->out};
    pg8::gemm_phase<true>(lds, S, E, 1024);
  }
}

DEVI void ph_mix1(KP P, int layer, int bid, int nblk, LAS unsigned char* lds) {
  s5_g1(P, bid, nblk, lds);
  ph_pool(P, layer, bid, nblk, lds);
  {
    LAS float* rpl = (LAS float*)lds;
    __syncthreads();
    for (int i = tidx(); i < 8 * 465; i += NT) rpl[i] = P->rpb[layer * 8 * 465 + i] * 1.4426950408889634f;
    __syncthreads();
    int t = tidx(), lane = t & 63, wave = t >> 6;
    LAS unsigned char* vb = lds + NA_VOFF + wave * (32 * NA_RS);
    if (wave < 4) {
      for (int u = bid * 8 + wave; u < 4096; u += nblk * 8) lru_unit<false>(P, layer, u, lane);
      for (int u = bid * 8 + wave; u < 16384; u += nblk * 8) na_unit(P, layer, u, lane, rpl, vb);
    } else {
      for (int u = bid * 8 + wave; u < 16384; u += nblk * 8) na_unit(P, layer, u, lane, rpl, vb);
      for (int u = bid * 8 + wave; u < 4096; u += nblk * 8) lru_unit<false>(P, layer, u, lane);
    }
  }
}
DEVI void ph_mix2(KP P, int layer, int bid, int nblk, LAS unsigned char* lds) {
  s5_g2(P, layer, bid, nblk, lds);
  int t = tidx(), lane = t & 63, wave = t >> 6;
  for (int u = bid * 8 + wave; u < 4096; u += nblk * 8) lru_unit<true>(P, layer, u, lane);
}


#define XB_TMO      128
#define XB_XCNT(j)  (256  + 64 * (j))
#define XB_XSUB(j)  (1280 + 64 * (j))
#define XB_XGEN(j)  (2304 + 64 * (j))
#define XB_TOP      3328
#define XB_TOPGEN   3392
#define XCD_BAR_WORDS 3456
#define XB_SPIN_CAP (1u << 18)
DEVI unsigned xb_ld(unsigned* p) { return __hip_atomic_load(p, __ATOMIC_RELAXED, __HIP_MEMORY_SCOPE_AGENT); }
DEVI unsigned xb_add(unsigned* p, unsigned v) { return __hip_atomic_fetch_add(p, v, __ATOMIC_RELAXED, __HIP_MEMORY_SCOPE_AGENT); }
DEVI unsigned xb_xcc_id() { return (unsigned)__builtin_amdgcn_s_getreg((3 << 11) | 20) & 0xFu; }
#define XB_SPIN(cond, bar) do { unsigned _sp = 0; while (cond) { __builtin_amdgcn_s_sleep(1); \
    if ((++_sp & 255u) == 0u) { if (xb_ld(&(bar)[XB_TMO])) break; if (_sp > XB_SPIN_CAP) { atomicAdd(&(bar)[XB_TMO], 1u); break; } } } } while (0)
DEVI void xcd_barrier_complete(unsigned* bar, unsigned x, unsigned& nloc, unsigned& nx) {
  const unsigned G = gridDim.x;
  unsigned sum, cnt, mine, sp = 0u;
  for (;;) {
    sum = 0u; cnt = 0u; mine = 0u;
#pragma unroll
    for (unsigned j = 0; j < 16; ++j) { const unsigned c = xb_ld(&bar[XB_XCNT(j)]); sum += c; cnt += (c > 0u) ? 1u : 0u; mine = (j == x) ? c : mine; }
    if (sum == G) break;
    __builtin_amdgcn_s_sleep(1);
    if ((++sp & 255u) == 0u) { if (xb_ld(&bar[XB_TMO])) break; if (sp > XB_SPIN_CAP) { atomicAdd(&bar[XB_TMO], 1u); break; } }
  }
  nloc = mine > 0u ? mine : 1u; nx = cnt > 0u ? cnt : 1u;
}
DEVI void xcd_barrier(unsigned* bar, volatile LAS unsigned* st) {
  asm volatile("s_waitcnt vmcnt(0)" ::: "memory");
  __syncthreads();
  if (threadIdx.x == 0) {
    const unsigned x = xb_xcc_id();
    __builtin_amdgcn_s_waitcnt(0);
    unsigned nloc = st[0], nx = st[1];
    if (nloc == 0u) { xcd_barrier_complete(bar, x, nloc, nx); st[0] = nloc; st[1] = nx; }
    const unsigned old = xb_add(&bar[XB_XSUB(x)], 1u);
    const unsigned gen = old / nloc;
    if (old + 1u == (gen + 1u) * nloc) {
      __builtin_amdgcn_fence(__ATOMIC_RELEASE, "agent");
      asm volatile("s_waitcnt vmcnt(0)" ::: "memory");
      const unsigned og = xb_add(&bar[XB_TOP], 1u);
      const unsigned tg = og / nx;
      if (og + 1u == (tg + 1u) * nx) xb_add(&bar[XB_TOPGEN], 1u);
      else XB_SPIN(xb_ld(&bar[XB_TOPGEN]) == tg, bar);
      __builtin_amdgcn_fence(__ATOMIC_ACQUIRE, "agent");
      xb_add(&bar[XB_XGEN(x)], 1u);
      asm volatile("s_waitcnt vmcnt(0)" ::: "memory");
    } else {
      XB_SPIN(xb_ld(&bar[XB_XGEN(x)]) == gen, bar);
      __builtin_amdgcn_fence(__ATOMIC_ACQUIRE, "agent");
      asm volatile("s_waitcnt vmcnt(0)" ::: "memory");
    }
  }
  __syncthreads();
}

constexpr int NPH = 18;
#ifndef PHMASK
#define PHMASK 0x1ff
#endif
template <int PH>
DEVI void run_ph(LAS unsigned char* lds, unsigned char* shm) {
  constexpr int layer = PH / 9, s = PH % 9;
  int bid = blockIdx.x, nblk = gridDim.x;
  KP P = getP();
  if constexpr (s == 0 && (PHMASK & 1)) {
    if (layer == 0) ph_wprep(P, bid, nblk, reinterpret_cast<float(*)[65]>(shm));
    ph_s5pre1(P, layer, bid, nblk, lds);
    ph_rmsnorm(P, layer, bid, nblk);
  }
  if constexpr (s == 1 && (PHMASK & 2)) {
    ph_s5pre2(P, bid, nblk);
    ph_gemm1(P, layer, bid, nblk, lds);
  }
  if constexpr (s == 2 && (PHMASK & 4)) ph_mix1(P, layer, bid, nblk, lds);
  if constexpr (s == 3 && (PHMASK & 8)) {
    ph_lru_carry(P, bid, nblk);
    ph_s5_carry(P, layer, bid, nblk);
  }
  if constexpr (s == 4 && (PHMASK & 16)) ph_mix2(P, layer, bid, nblk, lds);
  if constexpr (s == 5 && (PHMASK & 32)) ph_glu(P, layer, bid, nblk, lds);
  if constexpr (s == 6 && (PHMASK & 64)) ph_merge(P, layer, bid, nblk, lds);
  if constexpr (s == 7 && (PHMASK & 128)) ph_wout(P, layer, bid, nblk, lds);
  if constexpr (s == 8 && (PHMASK & 256)) ph_ple(P, layer, bid, nblk, lds);
}
__global__ void __launch_bounds__(512) mega(Params P_unused) {
  extern __shared__ __attribute__((aligned(16))) unsigned char shm[];
  LAS unsigned char* lds = (LAS unsigned char*)shm;
  cg::grid_group grid = cg::this_grid();
  volatile LAS unsigned* st = (volatile LAS unsigned*)(lds + pg8::STAGE_BYTES);
  if (threadIdx.x == 0) {
    st[0] = 0u; st[1] = 0u;
    KP Pq = getP();
    (void)xb_add(&Pq->bar[XB_XCNT(xb_xcc_id())], 1u);
  }
  __syncthreads();
#define RP(n) run_ph<n>(lds, shm)
#define GS() do { KP Pq = getP(); xcd_barrier(Pq->bar, st); } while (0)
  RP(0); grid.sync(); RP(1); GS(); RP(2); GS(); RP(3); GS(); RP(4); GS(); RP(5); GS();
  RP(6); GS(); RP(7); GS(); RP(8); GS();
  RP(9); GS(); RP(10); GS(); RP(11); GS(); RP(12); GS(); RP(13); GS(); RP(14); GS();
  RP(15); GS(); RP(16); GS(); RP(17);
#undef RP
#undef GS
}

extern "C" void kernel_launch(void* const* d_in, const int* in_sizes, int n_in, void* d_out, int out_size, void* d_ws,
                              size_t ws_size, hipStream_t stream) {
  Params P{};
  const float** pf = reinterpret_cast<const float**>(&P);
  for (int i = 0; i < 30; ++i) pf[i] = (const float*)d_in[i];
  P.out = (float*)d_out;
  char* w = (char*)d_ws;
  size_t off = 0;
  auto take = [&](size_t bytes) {
    char* r = w + off;
    off += (bytes + 255) & ~(size_t)255;
    return r;
  };
  P.wt_in = (u16*)take((size_t)2 * 9216 * 1024 * 2);
  P.wt_br = (u16*)take((size_t)8 * 1024 * 512 * 2);
  P.wt_out = (u16*)take((size_t)2 * 1024 * 1024 * 2);
  P.wt_pg = (u16*)take((size_t)2 * 1024 * 1024 * 2);
  P.wt_pp = (u16*)take((size_t)2 * 1024 * 256 * 2);
  P.wt_glu = (u16*)take((size_t)2 * 512 * 512 * 2);
  P.wt_pool = (u16*)take((size_t)8 * 128 * 128 * 2);
  P.wt_lr = (u16*)take((size_t)32 * 64 * 64 * 2);
  P.wt_li = (u16*)take((size_t)32 * 64 * 64 * 2);
  P.hn = (u16*)take((size_t)T * 1024 * 2);
  P.z = (u16*)take((size_t)T * NZ * 2);
  P.ub = (u16*)take((size_t)T * 512 * 2);
  P.w1 = (u16*)take((size_t)32 * 256 * 512 * 2);
  P.bg2 = (u16*)take((size_t)32 * 512 * 768 * 2);
  P.ecar = (u16*)take((size_t)32 * 1024 * 256 * 2);
  P.ktab = (float*)take((size_t)32 * 2 * 32 * 256 * 4);
  P.lagg = (float*)take((size_t)8 * 64 * 2 * 512 * 2 * 4);
  P.lcar = (float*)take((size_t)8 * 64 * 2 * 512 * 4);
  P.bar = (unsigned*)take((size_t)XCD_BAR_WORDS * 4);
  if (off > ws_size) {
    fprintf(stderr, "workspace too small: need %zu have %zu\n", off, ws_size);
    return;
  }
  static int grid_blocks = 0;
  if (!grid_blocks) {
    int dev = 0, cus = 0, per_cu = 0;
    (void)hipGetDevice(&dev);
    (void)hipDeviceGetAttribute(&cus, hipDeviceAttributeMultiprocessorCount, dev);
    (void)hipFuncSetAttribute((const void*)mega, hipFuncAttributeMaxDynamicSharedMemorySize, pg8::STAGE_BYTES + 16);
    (void)hipOccupancyMaxActiveBlocksPerMultiprocessor(&per_cu, mega, NT, pg8::STAGE_BYTES + 16);
    if (per_cu > 1) per_cu = 1;
    grid_blocks = cus * per_cu;
  }
  void* args[] = {&P};
  (void)hipMemsetAsync(P.bar, 0, (size_t)XCD_BAR_WORDS * 4, stream);
  hipError_t e = hipLaunchCooperativeKernel((void*)mega, dim3(grid_blocks), dim3(NT), args, pg8::STAGE_BYTES + 16, stream);
  if (e != hipSuccess) fprintf(stderr, "cooperative launch failed: %s (grid %d)\n", hipGetErrorString(e), grid_blocks);
}
```

```cpp
#include <hip/hip_runtime.h>
#include <hip/hip_cooperative_groups.h>
#include <cstdio>
namespace cg = cooperative_groups;

typedef __attribute__((ext_vector_type(8))) short bf16x8;
typedef __attribute__((ext_vector_type(4))) float f32x4;
typedef unsigned short u16;
#define DEVI __device__ __forceinline__

constexpr int T = 32768, NZ = 4608;
constexpr int ZA_X = 0, ZA_G = 512, ZQ = 1024, ZK = 1536, ZV = 2048, ZB_G = 2560, ZC_G = 3072,
              ZD_X = 3584, ZD_G = 4096, ZMRG = 1024, ZYG = 2048;

struct Params {
  const float *x, *p, *norm_scale, *w_in, *conv_w, *conv_b, *w_r, *b_r, *w_i, *b_i, *lam, *q_gain, *k_gain, *rpb,
      *a_re, *a_im, *log_dt, *sb_re, *sb_im, *sc_re, *sc_im, *s_d, *glu_w, *glu_b, *pool_w, *pool_scale, *w_branch,
      *w_out, *ple_proj, *ple_gate;
  float* out;
  u16 *wt_in, *wt_br, *wt_out, *wt_pg, *wt_pp, *wt_glu, *wt_pool, *wt_lr, *wt_li, *hn, *z, *w1, *bg2, *ecar, *ub;
  float *ktab, *lagg, *lcar;
  unsigned* bar;
};

typedef const Params __attribute__((address_space(4)))* KP;
__device__ __forceinline__ KP getP() {
  unsigned long long a = (unsigned long long)__builtin_amdgcn_kernarg_segment_ptr();
  unsigned lo = (unsigned)a, hi = (unsigned)(a >> 32);
  asm volatile("" : "+v"(lo), "+v"(hi));
  lo = __builtin_amdgcn_readfirstlane(lo);
  hi = __builtin_amdgcn_readfirstlane(hi);
  return (KP)(((unsigned long long)hi << 32) | lo);
}
DEVI int tidx() {
  int t = threadIdx.x;
  asm volatile("" : "+v"(t));
  return t;
}
DEVI unsigned pk2(float lo, float hi) {
  unsigned r;
  asm("v_cvt_pk_bf16_f32 %0, %1, %2" : "=v"(r) : "v"(lo), "v"(hi));
  return r;
}
DEVI u16 f2bf(float f) { return (u16)(pk2(f, f) & 0xffffu); }
DEVI float bf2f(u16 h) { return __uint_as_float(((unsigned)h) << 16); }
DEVI float bfs(short h) { return __uint_as_float(((unsigned)(u16)h) << 16); }
DEVI bf16x8 ld8(const u16* p) { return *reinterpret_cast<const bf16x8*>(p); }
DEVI float sigm(float x) { return __builtin_amdgcn_rcpf(1.f + __expf(-x)); }
DEVI float silu(float x) { return x * __builtin_amdgcn_rcpf(1.f + __expf(-x)); }
DEVI float gelu_t(float x) {
  float u = 0.7978845608028654f * (x + 0.044715f * x * x * x);
  float t = 1.f - 2.f * __builtin_amdgcn_rcpf(1.f + __expf(2.f * u));
  return 0.5f * x * (1.f + t);
}
typedef unsigned u32x4_t __attribute__((ext_vector_type(4)));
DEVI bf16x8 pack8(const float* v) {
  u32x4_t r = {pk2(v[0], v[1]), pk2(v[2], v[3]), pk2(v[4], v[5]), pk2(v[6], v[7])};
  return __builtin_bit_cast(bf16x8, r);
}
DEVI f32x4 mfma(bf16x8 a, bf16x8 b, f32x4 c) { return __builtin_amdgcn_mfma_f32_16x16x32_bf16(a, b, c, 0, 0, 0); }


#define LAS __attribute__((address_space(3)))
constexpr int NT = 512;
namespace pg8 {
constexpr int BM = 256, BK = 64, HALF = 128, HTB = HALF * BK * 2, STAGE_BYTES = 8 * HTB, NXCD = 8, WGM = 8;
DEVI int lds_byte(int r, int c) {
  const int st = (r >> 4) * 2 + (c >> 5), rr = r & 15, cc = c & 31, ob = rr * 64 + cc * 2;
  return st * 1024 + (ob ^ (((ob >> 9) & 1) << 5));
}
DEVI void stage_rc(int b, int& R, int& C) {
  const int st = b / 1024, sb = b % 1024, swz = sb ^ (((sb >> 9) & 1) << 5);
  R = (st >> 1) * 16 + swz / 64;
  C = (st & 1) * 32 + (swz % 64) / 2;
}
DEVI int perm32(int rho) { const int n = rho >> 4, i = rho & 15; return 8 * (i >> 2) + 4 * n + (i & 3); }
struct Unit { int pm, pn, g; };
DEVI void tile_of(int L, int nM, int nN, int& pm, int& pn) {
  const int nwg = nM * nN;
  int wgid = L;
  { const int q = nwg / NXCD, r = nwg % NXCD, xcd = wgid % NXCD, off = wgid / NXCD; wgid = (xcd < r ? xcd * (q + 1) : r * (q + 1) + (xcd - r) * q) + off; }
  const int nig = WGM * nN, gid = wgid / nig, fm = gid * WGM, gsz = (nM - fm) < WGM ? (nM - fm) : WGM;
  pm = fm + ((wgid % nig) % gsz);
  pn = (wgid % nig) / gsz;
}
struct SchedStd {
  const char* A; const char* B; unsigned lda2, ldb2; int nM, nN, c, G;
  DEVI bool next(int i, Unit& u) const {
    const int L = i * G + c;
    if (L >= nM * nN) return false;
    tile_of(L, nM, nN, u.pm, u.pn); u.g = 0;
    return true;
  }
  DEVI const char* a_base(const Unit& u) const { return A + (size_t)u.pm * 256 * lda2; }
  DEVI const char* b_base(const Unit& u) const { return B + (size_t)u.pn * 256 * ldb2; }
  DEVI unsigned a_voff(int R, int C) const { return (unsigned)R * lda2 + C * 2; }
  DEVI unsigned b_voff(int R, int C) const { return (unsigned)R * ldb2 + C * 2; }
  DEVI size_t a_kstep() const { return 128; }
  DEVI size_t b_kstep() const { return 128; }
  DEVI size_t a_hstep() const { return (size_t)128 * lda2; }
  DEVI size_t b_hstep() const { return (size_t)128 * ldb2; }
};

template <bool PERM, class Sched, class Epi>
DEVI void gemm_phase(LAS unsigned char* lds, const Sched& S, const Epi& E, const int K) {
  int tid_ = tidx();
  const int tid = tid_, wid = __builtin_amdgcn_readfirstlane(tid >> 6), lane = tid & 63, wr = wid >> 2, wc = wid & 3, fr = lane & 15, fq = lane >> 4;
  const int nt = K / BK;
  unsigned voffA[2], voffB[2];
#pragma unroll
  for (int i = 0; i < 2; ++i) {
    int R, C;
    stage_rc(tid * 16 + i * 8192, R, C);
    const int Rb = PERM ? ((R & ~31) + perm32(R & 31)) : R;
    voffA[i] = S.a_voff(R, C);
    voffB[i] = S.b_voff(Rb, C);
  }
  const size_t kA = S.a_kstep(), kB = S.b_kstep(), hA = S.a_hstep(), hB = S.b_hstep();
  const unsigned ldsw = (unsigned)wid * 1024u;
  const int aoff = lds_byte(wr * 64 + fr, fq * 8), boff = lds_byte(wc * 32 + fr, fq * 8);
#define PG8_SA(b, h) (((b) * 2 + (h)) * HTB)
#define PG8_SB(b, h) ((4 + (b) * 2 + (h)) * HTB)
#define PG8_STAGE(bufoff, gbase, voff) do { _Pragma("unroll") for (int _i = 0; _i < 2; ++_i) \
    __builtin_amdgcn_global_load_lds((const unsigned*)((const char*)(gbase) + (voff)[_i]), (LAS unsigned*)(lds + (bufoff) + ldsw + _i * 8192), 16, 0, 0); } while (0)
#define PG8_LDA(dst, b, h) do { _Pragma("unroll") for (int m = 0; m < 4; ++m) _Pragma("unroll") for (int k = 0; k < 2; ++k) dst[m][k] = *(const LAS bf16x8*)(lds + PG8_SA(b, h) + aoff + m * 2048 + k * 1024); } while (0)
#define PG8_LDB(dst, b, h) do { _Pragma("unroll") for (int n = 0; n < 2; ++n) _Pragma("unroll") for (int k = 0; k < 2; ++k) dst[n][k] = *(const LAS bf16x8*)(lds + PG8_SB(b, h) + boff + n * 2048 + k * 1024); } while (0)
#define PG8_MMA(ai, bj, At, Bt) do { __builtin_amdgcn_s_setprio(1); _Pragma("unroll") for (int m = 0; m < 4; ++m) _Pragma("unroll") for (int n = 0; n < 2; ++n) _Pragma("unroll") for (int k = 0; k < 2; ++k) \
    acc[ai][bj][m][n] = __builtin_amdgcn_mfma_f32_16x16x32_bf16(Bt[n][k], At[m][k], acc[ai][bj][m][n], 0, 0, 0); __builtin_amdgcn_s_setprio(0); } while (0)
#define PG8_WAIT_V(n) asm volatile("s_waitcnt vmcnt(" #n ")" ::: "memory")
#define PG8_WAIT_L(n) asm volatile("s_waitcnt lgkmcnt(" #n ")" ::: "memory")
#define PG8_BAR __builtin_amdgcn_s_barrier()
#define PG8_SCHED __builtin_amdgcn_sched_barrier(0)
  Unit cur, nxt;
  int ui = 0;
  if (!S.next(0, cur)) return;
  f32x4 acc[2][2][4][2];
#pragma unroll
  for (int a = 0; a < 2; ++a)
#pragma unroll
    for (int b = 0; b < 2; ++b)
#pragma unroll
      for (int m = 0; m < 4; ++m)
#pragma unroll
        for (int n = 0; n < 2; ++n) acc[a][b][m][n] = (f32x4){0.f, 0.f, 0.f, 0.f};
  bf16x8 At[4][2], B0[2][2], B1[2][2];
  const char* cA = S.a_base(cur);
  const char* cB = S.b_base(cur);
  PG8_STAGE(PG8_SB(0, 0), cB, voffB); PG8_STAGE(PG8_SA(0, 0), cA, voffA); PG8_STAGE(PG8_SB(0, 1), cB + hB, voffB); PG8_STAGE(PG8_SA(0, 1), cA + hA, voffA);
  if (wr == 1) PG8_BAR;
  PG8_WAIT_V(4); PG8_BAR;
  PG8_STAGE(PG8_SB(1, 0), cB + kB, voffB); PG8_STAGE(PG8_SA(1, 0), cA + kA, voffA); PG8_STAGE(PG8_SB(1, 1), cB + hB + kB, voffB);
  PG8_WAIT_V(6); PG8_BAR;
  for (;;) {
    const bool has_next = S.next(ui + 1, nxt);
    const char* nA = has_next ? S.a_base(nxt) : cA;
    const char* nB = has_next ? S.b_base(nxt) : cB;
    for (int t = 0; t < nt; t += 2) {
      const bool last = (t == nt - 2);
      const char* a1 = cA + (size_t)(t + 1) * kA;
      const char* a2 = last ? nA : cA + (size_t)(t + 2) * kA;
      const char* b2 = last ? nB : cB + (size_t)(t + 2) * kB;
      const char* a3 = a2 + kA;
      const char* b3 = b2 + kB;
      PG8_LDB(B0, 0, 0); PG8_SCHED; PG8_LDA(At, 0, 0); PG8_STAGE(PG8_SA(1, 1), a1 + hA, voffA);
      PG8_WAIT_L(8); PG8_BAR; PG8_WAIT_L(0); PG8_MMA(0, 0, At, B0); PG8_BAR; PG8_SCHED;
      PG8_LDB(B1, 0, 1); PG8_STAGE(PG8_SB(0, 0), b2, voffB);
      PG8_BAR; PG8_WAIT_L(0); PG8_MMA(0, 1, At, B1); PG8_BAR;
      PG8_LDA(At, 0, 1); PG8_STAGE(PG8_SA(0, 0), a2, voffA);
      PG8_BAR; PG8_WAIT_L(0); PG8_MMA(1, 0, At, B0); PG8_BAR; PG8_SCHED;
      PG8_STAGE(PG8_SB(0, 1), b2 + hB, voffB);
      PG8_WAIT_V(6); PG8_BAR; PG8_MMA(1, 1, At, B1); PG8_BAR;
      PG8_LDB(B0, 1, 0); PG8_SCHED; PG8_LDA(At, 1, 0); PG8_STAGE(PG8_SA(0, 1), a2 + hA, voffA);
      PG8_WAIT_L(8); PG8_BAR; PG8_WAIT_L(0); PG8_MMA(0, 0, At, B0); PG8_BAR; PG8_SCHED;
      PG8_LDB(B1, 1, 1); PG8_STAGE(PG8_SB(1, 0), b3, voffB);
      PG8_BAR; PG8_WAIT_L(0); PG8_MMA(0, 1, At, B1); PG8_BAR;
      PG8_LDA(At, 1, 1); PG8_STAGE(PG8_SA(1, 0), a3, voffA);
      PG8_BAR; PG8_WAIT_L(0); PG8_MMA(1, 0, At, B0); PG8_BAR; PG8_SCHED;
      PG8_STAGE(PG8_SB(1, 1), b3 + hB, voffB);
      PG8_WAIT_V(6); PG8_BAR; PG8_MMA(1, 1, At, B1); PG8_BAR;
    }
    { const int l2 = tidx() & 63; E(acc, cur, wr, wc, l2 & 15, l2 >> 4); }
    if (!has_next) break;
    bool keep = false;
    if constexpr (Epi::CHAIN) keep = E.keep(cur);
    if (!keep)
#pragma unroll
    for (int a = 0; a < 2; ++a)
#pragma unroll
      for (int b = 0; b < 2; ++b)
#pragma unroll
        for (int m = 0; m < 4; ++m)
#pragma unroll
          for (int n = 0; n < 2; ++n) acc[a][b][m][n] = (f32x4){0.f, 0.f, 0.f, 0.f};
    cur = nxt; cA = nA; cB = nB; ++ui;
  }
  PG8_WAIT_V(0);
  if (wr == 0) PG8_BAR;
  PG8_BAR;
#undef PG8_SA
#undef PG8_SB
#undef PG8_STAGE
#undef PG8_LDA
#undef PG8_LDB
#undef PG8_MMA
#undef PG8_WAIT_V
#undef PG8_WAIT_L
#undef PG8_BAR
#undef PG8_SCHED
}
}
typedef f32x4 Acc8[2][2][4][2];
typedef unsigned u32x4 __attribute__((ext_vector_type(4)));
DEVI float lo16(unsigned v) { return __uint_as_float(v << 16); }
DEVI float hi16(unsigned v) { return __uint_as_float(v & 0xffff0000u); }

template <class AF, class BF>
DEVI void mma_loop(f32x4 (&acc)[4][4], int K, AF af, BF bf) {
  for (int k0 = 0; k0 < K; k0 += 32) {
    bf16x8 a[4], b[4];
#pragma unroll
    for (int i = 0; i < 4; ++i) a[i] = af(i, k0);
#pragma unroll
    for (int i = 0; i < 4; ++i) b[i] = bf(i, k0);
#pragma unroll
    for (int i = 0; i < 4; ++i)
#pragma unroll
      for (int j = 0; j < 4; ++j) acc[i][j] = mfma(a[i], b[j], acc[i][j]);
  }
}
DEVI void zero_acc(f32x4 (&acc)[4][4]) {
#pragma unroll
  for (int i = 0; i < 4; ++i)
#pragma unroll
    for (int j = 0; j < 4; ++j) acc[i][j] = f32x4{0.f, 0.f, 0.f, 0.f};
}

DEVI void tconv(const float* src, u16* dst, int nb, int K, int N, int bid, int nblk, float (*tile)[65]) {
  int tx = tidx() & 63, ty = tidx() >> 6;
  int tk = K / 64, tn = N / 64, nt = nb * tk * tn;
  for (int t = bid; t < nt; t += nblk) {
    int mb = t / (tk * tn), r = t % (tk * tn), k0 = (r / tn) * 64, n0 = (r % tn) * 64;
#pragma unroll
    for (int i = 0; i < 8; ++i) tile[ty + 8 * i][tx] = src[((size_t)mb * K + k0 + ty + 8 * i) * N + n0 + tx];
    __syncthreads();
#pragma unroll
    for (int i = 0; i < 8; ++i) dst[((size_t)mb * N + n0 + ty + 8 * i) * K + k0 + tx] = f2bf(tile[tx][ty + 8 * i]);
    __syncthreads();
  }
}

DEVI void ph_wprep(KP P, int bid, int nblk, float (*tile)[65]) {
  tconv(P->w_in, P->wt_in, 2, 1024, 9216, bid, nblk, tile);
  tconv(P->w_branch, P->wt_br, 8, 512, 1024, bid, nblk, tile);
  tconv(P->w_out, P->wt_out, 2, 1024, 1024, bid, nblk, tile);
  tconv(P->ple_gate, P->wt_pg, 2, 1024, 1024, bid, nblk, tile);
  tconv(P->ple_proj, P->wt_pp, 2, 256, 1024, bid, nblk, tile);
  tconv(P->glu_w, P->wt_glu, 2, 512, 512, bid, nblk, tile);
  tconv(P->pool_w, P->wt_pool, 8, 128, 128, bid, nblk, tile);
  tconv(P->w_r, P->wt_lr, 32, 64, 64, bid, nblk, tile);
  tconv(P->w_i, P->wt_li, 32, 64, 64, bid, nblk, tile);
}

DEVI void ph_rmsnorm(KP P, int layer, int bid, int nblk) {
  int lane = tidx() & 63, wave = tidx() >> 6;
  const float* xin = layer == 0 ? P->x : P->out;
  const float4* g4 = reinterpret_cast<const float4*>(P->norm_scale + layer * 1024);
  for (int t = bid * 8 + wave; t < T; t += nblk * 8) {
    const float4* x4 = reinterpret_cast<const float4*>(xin + (size_t)t * 1024);
    float4 v[4];
    float ss = 0.f;
#pragma unroll
    for (int i = 0; i < 4; ++i) {
      v[i] = x4[lane + 64 * i];
      ss += v[i].x * v[i].x + v[i].y * v[i].y + v[i].z * v[i].z + v[i].w * v[i].w;
    }
#pragma unroll
    for (int o = 32; o >= 1; o >>= 1) ss += __shfl_xor(ss, o);
    float rinv = rsqrtf(ss * (1.f / 1024.f) + 1e-6f);
#pragma unroll
    for (int i = 0; i < 4; ++i) {
      float4 g = g4[lane + 64 * i];
      uint2 o;
      o.x = pk2(v[i].x * rinv * g.x, v[i].y * rinv * g.y);
      o.y = pk2(v[i].z * rinv * g.z, v[i].w * rinv * g.w);
      *reinterpret_cast<uint2*>(P->hn + (size_t)t * 1024 + (lane + 64 * i) * 4) = o;
    }
  }
}

struct CP { float lr, li, dt, fr, fi; };
DEVI void sincos_rev(float x, float& sn, float& cs) {
  float rev = x * 0.15915494309189535f;
  rev -= rintf(rev);
  sn = __builtin_amdgcn_sinf(rev);
  cs = __builtin_amdgcn_cosf(rev);
}
DEVI CP s5p(KP P, int layer, int d, int g, int p) {
  int i1 = (layer * 2 + d) * 32 + g;
  CP c;
  c.lr = fminf(P->a_re[i1 * 64 + p], -1e-4f);
  c.li = P->a_im[i1 * 64 + p];
  c.dt = expf(P->log_dt[i1]);
  float mag = expf(c.lr * c.dt), sn = sinf(c.li * c.dt), cs = cosf(c.li * c.dt);
  float abr = mag * cs, abi = mag * sn, nr = abr - 1.f, den = c.lr * c.lr + c.li * c.li;
  c.fr = (nr * c.lr + abi * c.li) / den;
  c.fi = (abi * c.lr - nr * c.li) / den;
  return c;
}
DEVI void cpow(const CP& c, float e, float& pr, float& pi) {
  float m = expf(e * c.lr * c.dt), sn, cs;
  sincos_rev(e * c.li * c.dt, sn, cs);
  pr = m * cs;
  pi = m * sn;
}

DEVI void ph_s5pre1(KP P, int layer, int bid, int nblk, LAS unsigned char* lds) {
  int gtid = bid * NT + tidx(), gstride = nblk * NT;
  LAS float* cps = (LAS float*)lds;
  for (int idx = gtid; idx < 32 * 2 * 32 * 16; idx += gstride) {
    int co = idx & 15, tau = (idx >> 4) & 31, d = (idx >> 9) & 1, g = idx >> 10;
    int i1 = (layer * 2 + d) * 32 + g;
    __syncthreads();
    if (tidx() < 64) {
      CP c0 = s5p(P, layer, d, g, tidx());
      LAS float* o = cps + tidx() * 5;
      o[0] = c0.lr; o[1] = c0.li; o[2] = c0.dt; o[3] = c0.fr; o[4] = c0.fi;
    }
    __syncthreads();
    float acc[16];
#pragma unroll
    for (int i = 0; i < 16; ++i) acc[i] = 0.f;
    for (int p = 0; p < 64; ++p) {
      CP c;
      c.lr = cps[p * 5]; c.li = cps[p * 5 + 1]; c.dt = cps[p * 5 + 2]; c.fr = cps[p * 5 + 3]; c.fi = cps[p * 5 + 4];
      float pr, pi;
      cpow(c, (float)tau, pr, pi);
      float cr = P->sc_re[((size_t)i1 * 16 + co) * 64 + p], ci = P->sc_im[((size_t)i1 * 16 + co) * 64 + p];
      float g1r = cr * pr - ci * pi, g1i = cr * pi + ci * pr;
      float gr = g1r * c.fr - g1i * c.fi, gi = g1r * c.fi + g1i * c.fr;
      const float* br = P->sb_re + ((size_t)i1 * 64 + p) * 16;
      const float* bi = P->sb_im + ((size_t)i1 * 64 + p) * 16;
#pragma unroll
      for (int i = 0; i < 16; ++i) acc[i] += gr * br[i] - gi * bi[i];
    }
    float* o = P->ktab + (size_t)idx * 16;
#pragma unroll
    for (int i = 0; i < 16; ++i) o[i] = acc[i];
  }
  for (int idx = gtid; idx < 32 * 2 * 64 * 32; idx += gstride) {
    int i = idx & 31, p = (idx >> 5) & 63, d = (idx >> 11) & 1, g = idx >> 12;
    int i1 = (layer * 2 + d) * 32 + g;
    CP c = s5p(P, layer, d, g, p);
    float pr, pi;
    cpow(c, d == 0 ? (float)(31 - i) : (float)i, pr, pi);
    float qr = pr * c.fr - pi * c.fi, qi = pr * c.fi + pi * c.fr;
    const float* br = P->sb_re + ((size_t)i1 * 64 + p) * 16;
    const float* bi = P->sb_im + ((size_t)i1 * 64 + p) * 16;
    u16* ore = P->w1 + ((size_t)g * 256 + d * 128 + p) * 512 + i * 16;
    u16* oim = ore + (size_t)64 * 512;
#pragma unroll
    for (int ci = 0; ci < 16; ++ci) {
      ore[ci] = f2bf(qr * br[ci] - qi * bi[ci]);
      oim[ci] = f2bf(qr * bi[ci] + qi * br[ci]);
    }
  }
  for (int idx = gtid; idx < 32 * 2 * 32 * 64; idx += gstride) {
    int p = idx & 63, j = (idx >> 6) & 31, d = (idx >> 11) & 1, g = idx >> 12;
    int i1 = (layer * 2 + d) * 32 + g;
    CP c = s5p(P, layer, d, g, p);
    float pr, pi;
    cpow(c, d == 0 ? (float)(j + 1) : (float)(32 - j), pr, pi);
    for (int co = 0; co < 16; ++co) {
      float cr = P->sc_re[((size_t)i1 * 16 + co) * 64 + p], ci = P->sc_im[((size_t)i1 * 16 + co) * 64 + p];
      float gr = cr * pr - ci * pi, gi = cr * pi + ci * pr;
      u16* o = P->bg2 + ((size_t)g * 512 + j * 16 + co) * 768 + 512 + d * 128 + p;
      o[0] = f2bf(gr);
      o[64] = f2bf(-gi);
    }
  }
}
DEVI void ph_s5pre2(KP P, int bid, int nblk) {
  int gtid = bid * NT + tidx(), gstride = nblk * NT;
  for (int idx = gtid; idx < 32 * 32 * 16 * 32; idx += gstride) {
    int i = idx & 31, co = (idx >> 5) & 15, j = (idx >> 9) & 31, g = idx >> 14;
    float v[16];
#pragma unroll
    for (int ci = 0; ci < 16; ++ci) v[ci] = 0.f;
    if (i <= j) {
      const float* k = P->ktab + ((((size_t)g * 2 + 0) * 32 + (j - i)) * 16 + co) * 16;
#pragma unroll
      for (int ci = 0; ci < 16; ++ci) v[ci] += k[ci];
    }
    if (i >= j) {
      const float* k = P->ktab + ((((size_t)g * 2 + 1) * 32 + (i - j)) * 16 + co) * 16;
#pragma unroll
      for (int ci = 0; ci < 16; ++ci) v[ci] += k[ci];
    }
    u16* o = P->bg2 + ((size_t)g * 512 + j * 16 + co) * 768 + i * 16;
#pragma unroll
    for (int ci = 0; ci < 16; ++ci) o[ci] = f2bf(v[ci]);
  }
}

struct EpiZ {
  static constexpr bool CHAIN = false;
  u16* O; unsigned ldo;
  DEVI void operator()(const Acc8& acc, const pg8::Unit& u, int wr, int wc, int fr, int fq) const {
    const int row0 = u.pm * 256 + wr * 64 + fr, col0 = u.pn * 256 + wc * 32 + 8 * fq;
#pragma unroll
    for (int ai = 0; ai < 2; ++ai)
#pragma unroll
      for (int m = 0; m < 4; ++m) {
        u16* rowp = O + (size_t)(row0 + ai * 128 + m * 16) * ldo + col0;
#pragma unroll
        for (int bj = 0; bj < 2; ++bj) {
          f32x4 v0 = acc[ai][bj][m][0], v1 = acc[ai][bj][m][1];
          u32x4 o = {pk2(v0[0], v0[1]), pk2(v0[2], v0[3]), pk2(v1[0], v1[1]), pk2(v1[2], v1[3])};
          *(u32x4*)(rowp + bj * 128) = o;
        }
      }
  }
};
struct EpiZ1 {
  static constexpr bool CHAIN = false;
  u16* z; u16* ub;
  DEVI void operator()(const Acc8& acc, const pg8::Unit& u, int wr, int wc, int fr, int fq) const {
    const int row0 = u.pm * 256 + wr * 64 + fr, cl0 = wc * 32 + 8 * fq;
    const bool cx = (u.pn == 12 || u.pn == 13);
    const int zc = u.pn * 256 - (u.pn >= 14 ? 512 : 0);
#pragma unroll
    for (int ai = 0; ai < 2; ++ai)
#pragma unroll
      for (int m = 0; m < 4; ++m) {
        const unsigned r = row0 + ai * 128 + m * 16;
#pragma unroll
        for (int bj = 0; bj < 2; ++bj) {
          f32x4 v0 = acc[ai][bj][m][0], v1 = acc[ai][bj][m][1];
          u32x4 o = {pk2(v0[0], v0[1]), pk2(v0[2], v0[3]), pk2(v1[0], v1[1]), pk2(v1[2], v1[3])};
          const int cl = cl0 + bj * 128;
          if (cx) {
            const int c = (u.pn - 12) * 256 + cl;
            *(u32x4*)(ub + (((unsigned)(c >> 4) * T + r) * 16u + (c & 15))) = o;
          } else {
            *(u32x4*)(z + (r * NZ + zc + cl)) = o;
          }
        }
      }
  }
};
DEVI void ph_gemm1(KP P, int layer, int bid, int nblk, LAS unsigned char* lds) {
  pg8::SchedStd S{(const char*)P->hn, (const char*)(P->wt_in + (size_t)layer * 9216 * 1024), 2048u, 2048u, 128, 20, bid, nblk};
  EpiZ1 E{P->z, P->ub};
  pg8::gemm_phase<true>(lds, S, E, 1024);
}

constexpr int PL_XS = 272;
constexpr int PL_POFF = 144 * PL_XS;
DEVI void ph_pool(KP P, int layer, int bid, int nblk, LAS unsigned char* lds) {
  const int tid = tidx(), lane = tid & 63, wave = tid >> 6, l15 = lane & 15, q4 = lane >> 4;
  const bool skew = (nblk == 256);
  const int nmine = skew ? (bid < 128 ? 2 : 6) : (1024 - bid + nblk - 1) / nblk;
  for (int k = 0; k < nmine; ++k) {
    const int it = skew ? (bid < 128 ? 768 + bid + 128 * k : (bid - 128) + 128 * k) : bid + k * nblk;
    const int tm = it >> 2, g = it & 3;
    const int win = 2 << g, half = win >> 1;
    const int t0 = tm * 128, s0 = t0 & 4095;
    const unsigned tbase = (unsigned)(t0 - s0);
    __syncthreads();
    for (int idx = tid; idx < 144 * 16; idx += NT) {
      const int r = idx >> 4, c = idx & 15, sq = s0 - 8 + r;
      u32x4_t v = {0u, 0u, 0u, 0u};
      if (sq >= 0 && sq < 4096) v = *(const u32x4_t*)(P->z + ((tbase + sq) * NZ + ZD_X + g * 128 + c * 8));
      *(LAS u32x4_t*)(lds + r * PL_XS + c * 16) = v;
    }
    __syncthreads();
    {
      const int c = tid & 15, strip = tid >> 4;
      float acc[8];
#pragma unroll
      for (int e = 0; e < 8; ++e) acc[e] = 0.f;
      const int j0 = strip * 4;
      const LAS unsigned char* xb = lds + c * 16;
      for (int w = 0; w < win; ++w) {
        const u32x4_t v = *(const LAS u32x4_t*)(xb + (j0 + 8 - half + w) * PL_XS);
#pragma unroll
        for (int e = 0; e < 4; ++e) { acc[2 * e] += lo16(v[e]); acc[2 * e + 1] += hi16(v[e]); }
      }
#pragma unroll
      for (int j = 0; j < 4; ++j) {
        const int sq = s0 + j0 + j;
        const int lo = max(sq - half, 0), hi = min(sq - half + win, 4096);
        const float ic = __builtin_amdgcn_rcpf((float)(hi - lo));
        const u32x4_t self = *(const LAS u32x4_t*)(xb + (j0 + j + 8) * PL_XS);
        float o[8];
#pragma unroll
        for (int e = 0; e < 4; ++e) { o[2 * e] = acc[2 * e] * ic - lo16(self[e]); o[2 * e + 1] = acc[2 * e + 1] * ic - hi16(self[e]); }
        *(LAS u32x4_t*)(lds + PL_POFF + (j0 + j) * PL_XS + c * 16) = (u32x4_t){pk2(o[0], o[1]), pk2(o[2], o[3]), pk2(o[4], o[5]), pk2(o[6], o[7])};
        if (j < 3) {
          const u32x4_t vin = *(const LAS u32x4_t*)(xb + (j0 + j + 8 - half + win) * PL_XS);
          const u32x4_t vout = *(const LAS u32x4_t*)(xb + (j0 + j + 8 - half) * PL_XS);
#pragma unroll
          for (int e = 0; e < 4; ++e) { acc[2 * e] += lo16(vin[e]) - lo16(vout[e]); acc[2 * e + 1] += hi16(vin[e]) - hi16(vout[e]); }
        }
      }
    }
    __syncthreads();
    {
      const int r0 = (wave >> 1) * 32, n0 = (wave & 1) * 64;
      const u16* bp = P->wt_pool + ((size_t)(layer * 4 + g) * 128 + n0 + l15) * 128 + q4 * 8;
      f32x4 acc[2][4];
#pragma unroll
      for (int i = 0; i < 2; ++i)
#pragma unroll
        for (int j = 0; j < 4; ++j) acc[i][j] = f32x4{0.f, 0.f, 0.f, 0.f};
#pragma unroll
      for (int k0 = 0; k0 < 128; k0 += 32) {
        bf16x8 a[2], bfr[4];
#pragma unroll
        for (int i = 0; i < 2; ++i) a[i] = *(const LAS bf16x8*)(lds + PL_POFF + (r0 + i * 16 + l15) * PL_XS + (k0 + q4 * 8) * 2);
#pragma unroll
        for (int j = 0; j < 4; ++j) bfr[j] = ld8(bp + (size_t)j * 16 * 128 + k0);
#pragma unroll
        for (int i = 0; i < 2; ++i)
#pragma unroll
          for (int j = 0; j < 4; ++j) acc[i][j] = mfma(a[i], bfr[j], acc[i][j]);
      }
#pragma unroll
      for (int i = 0; i < 2; ++i)
#pragma unroll
        for (int j = 0; j < 4; ++j) {
          const int ch = g * 128 + n0 + j * 16 + l15;
          const float sc = P->pool_scale[layer * 512 + ch];
#pragma unroll
          for (int e = 0; e < 4; ++e) {
            const unsigned t = t0 + r0 + i * 16 + q4 * 4 + e;
            u16* zp = P->z + (t * NZ + ZD_G + ch);
            *zp = f2bf(acc[i][j][e] * sc * silu(bf2f(*zp)));
          }
        }
    }
  }
  __syncthreads();
}

template <bool FINAL>
DEVI void lru_unit(KP P, int layer, int u, int lane) {
  asm volatile("" : "+v"(lane));
  int l15 = lane & 15, q4 = lane >> 4;
  const float* cw = P->conv_w + layer * 4 * 512;
  const float* cb = P->conv_b + layer * 512;
  int b = u >> 9, c = (u >> 3) & 63, n = u & 7;
  int s0 = c * 64;
  unsigned tb = (unsigned)b * 4096u;
  bf16x8 xa[4][2];
#pragma unroll
  for (int ks = 0; ks < 2; ++ks) {
    int ch0 = n * 64 + ks * 32 + q4 * 8;
    float wv[4][8], bb[8];
#pragma unroll
    for (int e = 0; e < 8; ++e) bb[e] = cb[ch0 + e];
#pragma unroll
    for (int j = 0; j < 4; ++j)
#pragma unroll
      for (int e = 0; e < 8; ++e) wv[j][e] = cw[j * 512 + ch0 + e];
#pragma unroll
    for (int mt = 0; mt < 4; ++mt) {
      int s = s0 + mt * 16 + l15;
      float v[8];
#pragma unroll
      for (int e = 0; e < 8; ++e) v[e] = bb[e];
#pragma unroll
      for (int j = 0; j < 4; ++j) {
        int sj = s + j - 2;
        if (sj >= 0 && sj < 4096) {
          bf16x8 r = ld8(P->z + (unsigned)((tb + sj) * NZ + ZA_X + ch0));
#pragma unroll
          for (int e = 0; e < 8; ++e) v[e] += bfs(r[e]) * wv[j][e];
        }
      }
      xa[mt][ks] = pack8(v);
    }
    __builtin_amdgcn_sched_barrier(0);
  }
#pragma unroll 1
  for (int nt = 0; nt < 4; ++nt) {
    int ch = n * 64 + nt * 16 + l15;
    f32x4 xcv[4];
    {
#pragma unroll
      for (int mt = 0; mt < 4; ++mt) xcv[mt] = f32x4{0.f, 0.f, 0.f, 0.f};
#pragma unroll
      for (int ks = 0; ks < 2; ++ks) {
        bf16x8 id;
#pragma unroll
        for (int e = 0; e < 8; ++e) id[e] = (ks * 32 + q4 * 8 + e == nt * 16 + l15) ? (short)0x3f80 : (short)0;
#pragma unroll
        for (int mt = 0; mt < 4; ++mt) xcv[mt] = mfma(xa[mt][ks], id, xcv[mt]);
      }
    }
    float hout[4][4];
    u16 gav[4][4];
#pragma unroll
    for (int mt = 0; mt < 4; ++mt)
#pragma unroll
      for (int j = 0; j < 4; ++j) {
        hout[mt][j] = 0.f;
        if (FINAL) gav[mt][j] = P->z[(unsigned)((tb + s0 + mt * 16 + q4 * 4 + j) * NZ + ZA_G + ch)];
      }
    f32x4 ar[2][4], ai[2][4];
    float brb[2], bib[2], sp[2], h_run[2], p_run[2];
    size_t ci[2];
#pragma unroll
    for (int dir = 0; dir < 2; ++dir) {
#pragma unroll
      for (int mt = 0; mt < 4; ++mt) { ar[dir][mt] = f32x4{0.f, 0.f, 0.f, 0.f}; ai[dir][mt] = f32x4{0.f, 0.f, 0.f, 0.f}; }
      size_t wo = ((size_t)((layer * 2 + dir) * 8 + n) * 64 + nt * 16 + l15) * 64 + q4 * 8;
#pragma unroll
      for (int ks = 0; ks < 2; ++ks) {
        bf16x8 br = ld8(P->wt_lr + wo + ks * 32), bi = ld8(P->wt_li + wo + ks * 32);
#pragma unroll
        for (int mt = 0; mt < 4; ++mt) {
          ar[dir][mt] = mfma(xa[mt][ks], br, ar[dir][mt]);
          ai[dir][mt] = mfma(xa[mt][ks], bi, ai[dir][mt]);
        }
      }
      int pi = (layer * 2 + dir) * 512 + ch;
      brb[dir] = P->b_r[pi] * -1.4426950408889634f;
      bib[dir] = P->b_i[pi] * -1.4426950408889634f;
      sp[dir] = __logf(1.f + __expf(-P->lam[pi])) * (-8.f * 1.4426950408889634f);
      ci[dir] = (((size_t)b * 64 + c) * 2 + dir) * 512 + ch;
      h_run[dir] = FINAL ? P->lcar[ci[dir]] : 0.f;
      p_run[dir] = 1.f;
    }
#pragma unroll
    for (int mi = 0; mi < 4; ++mi) {
#pragma unroll
      for (int dir = 0; dir < 2; ++dir) {
        const int mt = dir == 0 ? mi : 3 - mi;
        float av[4], bv[4];
#pragma unroll
        for (int j = 0; j < 4; ++j) {
          float r = __builtin_amdgcn_rcpf(1.f + __builtin_amdgcn_exp2f(__builtin_fmaf(ar[dir][mt][j], -1.4426950408889634f, brb[dir])));
          float gi = __builtin_amdgcn_rcpf(1.f + __builtin_amdgcn_exp2f(__builtin_fmaf(ai[dir][mt][j], -1.4426950408889634f, bib[dir])));
          av[j] = __builtin_amdgcn_exp2f(r * sp[dir]);
          bv[j] = __builtin_amdgcn_sqrtf(__builtin_fmaf(-av[j], av[j], 1.f)) * (gi * xcv[mt][j]);
        }
        float Pl = av[0] * av[1] * av[2] * av[3], Hl;
        if (dir == 0) Hl = ((bv[0] * av[1] + bv[1]) * av[2] + bv[2]) * av[3] + bv[3];
        else Hl = ((bv[3] * av[2] + bv[2]) * av[1] + bv[1]) * av[0] + bv[0];
        float hq = h_run[dir];
#pragma unroll
        for (int qi = 0; qi < 3; ++qi) {
          int qq = dir == 0 ? qi : 3 - qi;
          float Pq = __shfl(Pl, l15 + 16 * qq), Hq = __shfl(Hl, l15 + 16 * qq);
          bool use = dir == 0 ? (qq < q4) : (qq > q4);
          if (use) hq = Pq * hq + Hq;
        }
        if (FINAL) {
          float h = hq;
#pragma unroll
          for (int ji = 0; ji < 4; ++ji) {
            int j = dir == 0 ? ji : 3 - ji;
            h = av[j] * h + bv[j];
            hout[mt][j] += h;
          }
        }
        float full = Pl * hq + Hl;
        h_run[dir] = __shfl(full, l15 + (dir == 0 ? 48 : 0));
        if (!FINAL) {
          float pt = Pl * __shfl_xor(Pl, 16);
          pt *= __shfl_xor(pt, 32);
          p_run[dir] *= pt;
        }
      }
    }
    if (!FINAL && q4 == 0) {
#pragma unroll
      for (int dir = 0; dir < 2; ++dir) {
        P->lagg[ci[dir] * 2] = p_run[dir];
        P->lagg[ci[dir] * 2 + 1] = h_run[dir];
      }
    }
    if (FINAL) {
#pragma unroll
      for (int mt = 0; mt < 4; ++mt)
#pragma unroll
        for (int j = 0; j < 4; ++j) {
          u16* zp = P->z + (unsigned)((tb + s0 + mt * 16 + q4 * 4 + j) * NZ + ZA_G + ch);
          *zp = f2bf(hout[mt][j] * silu(bf2f(gav[mt][j])));
        }
    }
  }
}

DEVI void ph_lru_carry(KP P, int bid, int nblk) {
  for (int idx = bid * NT + tidx(); idx < 8 * 2 * 512; idx += nblk * NT) {
    int ch = idx & 511, dir = (idx >> 9) & 1, b = idx >> 10;
    float h = 0.f;
    for (int c0 = 0; c0 < 64; c0 += 16) {
      float2 ag[16];
#pragma unroll
      for (int k = 0; k < 16; ++k) {
        const int c = dir == 0 ? c0 + k : 63 - (c0 + k);
        const size_t o = (((size_t)b * 64 + c) * 2 + dir) * 512 + ch;
        ag[k] = *(const float2*)(P->lagg + o * 2);
      }
#pragma unroll
      for (int k = 0; k < 16; ++k) {
        const int c = dir == 0 ? c0 + k : 63 - (c0 + k);
        const size_t o = (((size_t)b * 64 + c) * 2 + dir) * 512 + ch;
        P->lcar[o] = h;
        h = ag[k].x * h + ag[k].y;
      }
    }
  }
}

typedef __attribute__((ext_vector_type(2))) __bf16 bf2_t;
DEVI float dot2sq(unsigned x, float c) {
  bf2_t v = __builtin_bit_cast(bf2_t, x);
  return __builtin_amdgcn_fdot2_f32_bf16(v, v, c, false);
}
constexpr int NA_RS = 144;
constexpr int NA_VOFF = 16384;
DEVI void na_unit(KP P, int layer, int u, int lane, const LAS float* rpl, LAS unsigned char* vb) {
  asm volatile("" : "+v"(lane));
  const int l15 = lane & 15, q4 = lane >> 4;
  const int h = u & 7, jb = (u >> 3) & 3, r = (u >> 5) & 63, b = u >> 11;
  const int rs = min(max(r - 4, 0), 56);
  const int bs = min(max(16 * jb - 8, 0), 32);
  const unsigned tb = (unsigned)b * 4096u;
  const float LOG2E = 1.4426950408889634f;
  bf16x8 qf[2];
  {
    const unsigned tq = tb + r * 64 + jb * 16 + l15;
    u32x4_t raw[2];
    float ss = 0.f;
#pragma unroll
    for (int ks = 0; ks < 2; ++ks) {
      raw[ks] = *(const u32x4_t*)(P->z + (tq * NZ + ZQ + h * 64 + ks * 32 + q4 * 8));
#pragma unroll
      for (int e = 0; e < 4; ++e) ss = dot2sq(raw[ks][e], ss);
    }
    ss += __shfl_xor(ss, 16);
    ss += __shfl_xor(ss, 32);
    const float rq = rsqrtf(ss * (1.f / 64.f) + 1e-6f) * (0.125f * LOG2E);
#pragma unroll
    for (int ks = 0; ks < 2; ++ks) {
      const float* qg = P->q_gain + layer * 64 + ks * 32 + q4 * 8;
      const float* kg = P->k_gain + layer * 64 + ks * 32 + q4 * 8;
      float v[8];
#pragma unroll
      for (int e = 0; e < 4; ++e) {
        v[2 * e] = lo16(raw[ks][e]) * rq * qg[2 * e] * kg[2 * e];
        v[2 * e + 1] = hi16(raw[ks][e]) * rq * qg[2 * e + 1] * kg[2 * e + 1];
      }
      qf[ks] = pack8(v);
    }
  }
  u16 gv[4][4];
#pragma unroll
  for (int j = 0; j < 4; ++j)
#pragma unroll
    for (int dt = 0; dt < 4; ++dt) gv[j][dt] = P->z[(tb + r * 64 + jb * 16 + q4 * 4 + j) * NZ + ZB_G + h * 64 + dt * 16 + l15];
  const int qcol = jb * 16 + l15;
  const int ws = min(max(qcol - 8, 0), 48);
  unsigned vmask = 0;
  int dcx[2][4];
#pragma unroll
  for (int t = 0; t < 2; ++t)
#pragma unroll
    for (int j = 0; j < 4; ++j) {
      const int kcol = bs + 8 * q4 + 4 * t + j;
      if (kcol >= ws && kcol < ws + 16) vmask |= 1u << (t * 4 + j);
      dcx[t][j] = min(max(kcol - qcol, -15), 15) + 15;
    }
  const LAS float* rp = rpl + h * 465 + (rs - r + 7) * 31;
  const int kxa = 8 * (l15 >> 2) + (l15 & 3);
  const unsigned kbase = (tb + rs * 64 + bs + kxa) * NZ + ZK + h * 64 + q4 * 8;
  f32x4 sc[16];
  u32x4_t kq[16][2];
#pragma unroll
  for (int i = 0; i < 16; ++i) {
    const unsigned ko = kbase + (unsigned)((i >> 1) * 64 + 4 * (i & 1)) * NZ;
    kq[i][0] = *(const u32x4_t*)(P->z + ko);
    kq[i][1] = *(const u32x4_t*)(P->z + ko + 32);
  }
#pragma unroll
  for (int gi = 0; gi < 2; ++gi) {
    float rkv[8];
#pragma unroll
    for (int i = 0; i < 8; ++i) {
      const int nt = gi * 8 + i;
      float ss = 0.f;
#pragma unroll
      for (int e = 0; e < 4; ++e) { ss = dot2sq(kq[nt][0][e], ss); ss = dot2sq(kq[nt][1][e], ss); }
      ss += __shfl_xor(ss, 16);
      ss += __shfl_xor(ss, 32);
      rkv[i] = rsqrtf(ss * (1.f / 64.f) + 1e-6f);
      f32x4 a = f32x4{0.f, 0.f, 0.f, 0.f};
      a = mfma(__builtin_bit_cast(bf16x8, kq[nt][0]), qf[0], a);
      a = mfma(__builtin_bit_cast(bf16x8, kq[nt][1]), qf[1], a);
      sc[nt] = a;
    }
#pragma unroll
    for (int i = 0; i < 8; ++i) {
      const int nt = gi * 8 + i, kri = nt >> 1, t = nt & 1;
#pragma unroll
      for (int j = 0; j < 4; ++j) {
        const float rkj = __shfl(rkv[i], (lane & 48) + 4 * q4 + j);
        const float bias = rp[kri * 31 + dcx[t][j]];
        sc[nt][j] = ((vmask >> (t * 4 + j)) & 1u) ? sc[nt][j] * rkj + bias : -1e30f;
      }
    }
    __builtin_amdgcn_sched_barrier(0);
  }
  const unsigned vg0 = (tb + rs * 64 + bs + (lane >> 3)) * NZ + ZV + h * 64 + (lane & 7) * 8;
  u32x4_t vreg[8][4];
#pragma unroll
  for (int s8 = 0; s8 < 4; ++s8)
#pragma unroll
    for (int i = 0; i < 4; ++i) vreg[s8][i] = *(const u32x4_t*)(P->z + vg0 + (unsigned)(s8 * 64 + 8 * i) * NZ);
  float mx = -1e30f;
#pragma unroll
  for (int nt = 0; nt < 16; ++nt)
#pragma unroll
    for (int j = 0; j < 4; ++j) mx = fmaxf(mx, sc[nt][j]);
  mx = fmaxf(mx, __shfl_xor(mx, 16));
  mx = fmaxf(mx, __shfl_xor(mx, 32));
  float sum = 0.f;
#pragma unroll
  for (int nt = 0; nt < 16; ++nt)
#pragma unroll
    for (int j = 0; j < 4; ++j) {
      const float pv = __builtin_amdgcn_exp2f(sc[nt][j] - mx);
      sc[nt][j] = pv;
      sum += pv;
    }
  sum += __shfl_xor(sum, 16);
  sum += __shfl_xor(sum, 32);
  u32x4_t pfu[8];
#pragma unroll
  for (int s8 = 0; s8 < 8; ++s8)
    pfu[s8] = (u32x4_t){pk2(sc[2 * s8][0], sc[2 * s8][1]), pk2(sc[2 * s8][2], sc[2 * s8][3]), pk2(sc[2 * s8 + 1][0], sc[2 * s8 + 1][1]),
                        pk2(sc[2 * s8 + 1][2], sc[2 * s8 + 1][3])};
  __builtin_amdgcn_sched_barrier(0);
#pragma unroll
  for (int s8 = 4; s8 < 8; ++s8)
#pragma unroll
    for (int i = 0; i < 4; ++i) vreg[s8][i] = *(const u32x4_t*)(P->z + vg0 + (unsigned)(s8 * 64 + 8 * i) * NZ);
  f32x4 oacc[4];
#pragma unroll
  for (int dt = 0; dt < 4; ++dt) oacc[dt] = f32x4{0.f, 0.f, 0.f, 0.f};
  LAS unsigned char* vw = vb + (lane >> 3) * NA_RS + (lane & 7) * 16;
  const unsigned vr = (unsigned)(size_t)(vb + (8 * q4 + (l15 >> 2)) * NA_RS + 8 * (lane & 3));
#pragma unroll
  for (int s8 = 0; s8 < 8; ++s8) {
#pragma unroll
    for (int i = 0; i < 4; ++i) *(LAS u32x4_t*)(vw + 8 * i * NA_RS) = vreg[s8][i];
    typedef unsigned u32x2_t __attribute__((ext_vector_type(2)));
    u32x2_t t0, t1, t2, t3, t4, t5, t6, t7;
    asm volatile(
        "s_waitcnt lgkmcnt(0)\n\t"
        "ds_read_b64_tr_b16 %0, %8\n\t"
        "ds_read_b64_tr_b16 %1, %8 offset:576\n\t"
        "ds_read_b64_tr_b16 %2, %8 offset:32\n\t"
        "ds_read_b64_tr_b16 %3, %8 offset:608\n\t"
        "ds_read_b64_tr_b16 %4, %8 offset:64\n\t"
        "ds_read_b64_tr_b16 %5, %8 offset:640\n\t"
        "ds_read_b64_tr_b16 %6, %8 offset:96\n\t"
        "ds_read_b64_tr_b16 %7, %8 offset:672\n\t"
        "s_waitcnt lgkmcnt(0)"
        : "=&v"(t0), "=&v"(t1), "=&v"(t2), "=&v"(t3), "=&v"(t4), "=&v"(t5), "=&v"(t6), "=&v"(t7)
        : "v"(vr)
        : "memory");
    const bf16x8 pf = __builtin_bit_cast(bf16x8, pfu[s8]);
    oacc[0] = mfma(pf, __builtin_bit_cast(bf16x8, (u32x4_t){t0[0], t0[1], t1[0], t1[1]}), oacc[0]);
    oacc[1] = mfma(pf, __builtin_bit_cast(bf16x8, (u32x4_t){t2[0], t2[1], t3[0], t3[1]}), oacc[1]);
    oacc[2] = mfma(pf, __builtin_bit_cast(bf16x8, (u32x4_t){t4[0], t4[1], t5[0], t5[1]}), oacc[2]);
    oacc[3] = mfma(pf, __builtin_bit_cast(bf16x8, (u32x4_t){t6[0], t6[1], t7[0], t7[1]}), oacc[3]);
  }
#pragma unroll
  for (int j = 0; j < 4; ++j) {
    const float inv = __builtin_amdgcn_rcpf(__shfl(sum, q4 * 4 + j));
    const unsigned t = tb + r * 64 + jb * 16 + q4 * 4 + j;
#pragma unroll
    for (int dt = 0; dt < 4; ++dt) {
      u16* zp = P->z + (t * NZ + ZB_G + h * 64 + dt * 16 + l15);
      *zp = f2bf(oacc[dt][j] * inv * silu(bf2f(gv[j][dt])));
    }
  }
}

struct SchedS5U {
  const char* ub; const char* B; unsigned ldb2; size_t bgs;
  int nPN, nUnits, c, G;
  DEVI bool next(int i, pg8::Unit& u) const {
    const int L = i * G + c;
    if (L >= nUnits) return false;
    u.pn = L % nPN; u.pm = (L / nPN) & 3; u.g = L / (nPN * 4);
    return true;
  }
  DEVI const char* a_base(const pg8::Unit& u) const { return ub + ((size_t)u.g * 1024 + (size_t)u.pm * 256) * 1024; }
  DEVI const char* b_base(const pg8::Unit& u) const { return B + (size_t)u.g * bgs + (size_t)u.pn * 256 * ldb2; }
  DEVI unsigned a_voff(int R, int C) const { return (unsigned)R * 1024u + C * 2; }
  DEVI unsigned b_voff(int R, int C) const { return (unsigned)R * ldb2 + C * 2; }
  DEVI size_t a_kstep() const { return 128; }
  DEVI size_t b_kstep() const { return 128; }
  DEVI size_t a_hstep() const { return (size_t)128 * 1024; }
  DEVI size_t b_hstep() const { return (size_t)128 * ldb2; }
};
struct EpiE {
  static constexpr bool CHAIN = false;
  u16* O;
  DEVI void operator()(const Acc8& acc, const pg8::Unit& u, int wr, int wc, int fr, int fq) const {
    const int row0 = u.g * 1024 + u.pm * 256 + wr * 64 + fr, col0 = wc * 32 + 8 * fq;
#pragma unroll
    for (int ai = 0; ai < 2; ++ai)
#pragma unroll
      for (int m = 0; m < 4; ++m) {
        u16* rowp = O + (size_t)(row0 + ai * 128 + m * 16) * 256 + col0;
#pragma unroll
        for (int bj = 0; bj < 2; ++bj) {
          f32x4 v0 = acc[ai][bj][m][0], v1 = acc[ai][bj][m][1];
          u32x4 o = {pk2(v0[0], v0[1]), pk2(v0[2], v0[3]), pk2(v1[0], v1[1]), pk2(v1[2], v1[3])};
          *(u32x4*)(rowp + bj * 128) = o;
        }
      }
  }
};
DEVI void s5_g1(KP P, int bid, int nblk, LAS unsigned char* lds) {
  SchedS5U S{(const char*)P->ub, (const char*)P->w1, 1024u, (size_t)256 * 512 * 2, 1, 128, bid, nblk};
  EpiE E{P->ecar};
  pg8::gemm_phase<true>(lds, S, E, 512);
}

DEVI void ph_s5_carry(KP P, int layer, int bid, int nblk) {
  for (int idx = bid * NT + tidx(); idx < 8 * 32 * 2 * 64; idx += nblk * NT) {
    int p = idx & 63, d = (idx >> 6) & 1, g = (idx >> 7) & 31, b = idx >> 12;
    CP c = s5p(P, layer, d, g, p);
    float ar, ai;
    cpow(c, 32.f, ar, ai);
    float hr = 0.f, hi = 0.f;
    u16* base = P->ecar + ((size_t)g * 1024 + b * 128) * 256 + d * 128 + p;
    for (int c0 = 0; c0 < 128; c0 += 16) {
      u16 er[16], ei[16];
#pragma unroll
      for (int k = 0; k < 16; ++k) {
        const int cc = d == 0 ? c0 + k : 127 - (c0 + k);
        er[k] = base[(size_t)cc * 256];
        ei[k] = base[(size_t)cc * 256 + 64];
      }
#pragma unroll
      for (int k = 0; k < 16; ++k) {
        const int cc = d == 0 ? c0 + k : 127 - (c0 + k);
        base[(size_t)cc * 256] = f2bf(hr);
        base[(size_t)cc * 256 + 64] = f2bf(hi);
        const float nr = ar * hr - ai * hi + bf2f(er[k]), ni = ar * hi + ai * hr + bf2f(ei[k]);
        hr = nr;
        hi = ni;
      }
    }
  }
}

struct SchedS5C {
  const char* A; const char* B; int c, G;
  DEVI bool next(int i, pg8::Unit& u) const {
    const int L = i * G + c;
    if (L >= 256) return false;
    u.pn = L & 1; u.pm = (L >> 1) & 3; u.g = L >> 3;
    return true;
  }
  DEVI const char* a_base(const pg8::Unit& u) const { return A + ((size_t)u.g * 1024 + u.pm * 256) * 512; }
  DEVI const char* b_base(const pg8::Unit& u) const { return B + ((size_t)u.g * 512 + u.pn * 256) * 1536 + 1024; }
  DEVI unsigned a_voff(int R, int C) const { return (unsigned)R * 512u + C * 2; }
  DEVI unsigned b_voff(int R, int C) const { return (unsigned)R * 1536u + C * 2; }
  DEVI size_t a_kstep() const { return 128; }
  DEVI size_t b_kstep() const { return 128; }
  DEVI size_t a_hstep() const { return (size_t)128 * 512; }
  DEVI size_t b_hstep() const { return (size_t)128 * 1536; }
};
template <bool SECOND>
struct EpiYg {
  static constexpr bool CHAIN = false;
  u16* z; const u16* ub; const float* dsk;
  DEVI void operator()(const Acc8& acc, const pg8::Unit& u, int wr, int wc, int fr, int fq) const {
    const int m0 = u.pm * 256 + wr * 64 + fr, n00 = u.pn * 256 + wc * 32 + 8 * fq;
#pragma unroll
    for (int ai = 0; ai < 2; ++ai)
#pragma unroll
      for (int bj = 0; bj < 2; ++bj) {
        const int n0 = n00 + bj * 128;
        const int ch = u.g * 16 + (n0 & 15);
        f32x4 d0, d1;
        if (SECOND) { d0 = *(const f32x4*)(dsk + ch); d1 = *(const f32x4*)(dsk + ch + 4); }
#pragma unroll
        for (int mh = 0; mh < 2; ++mh) {
          u32x4 pp[2], uu[2];
          u16* yp[2];
#pragma unroll
          for (int mm = 0; mm < 2; ++mm) {
            const int m = mh * 2 + mm;
            const unsigned t = (unsigned)(m0 + ai * 128 + m * 16) * 32u + (n0 >> 4);
            yp[mm] = z + (t * NZ + ZYG + ch);
            if (SECOND) {
              pp[mm] = *(const u32x4*)yp[mm];
              uu[mm] = *(const u32x4*)(ub + (((unsigned)u.g * T + t) * 16u + (n0 & 15)));
            }
          }
#pragma unroll
          for (int mm = 0; mm < 2; ++mm) {
            const int m = mh * 2 + mm;
            f32x4 v0 = acc[ai][bj][m][0], v1 = acc[ai][bj][m][1];
            float v[8] = {v0[0], v0[1], v0[2], v0[3], v1[0], v1[1], v1[2], v1[3]};
            if (SECOND) {
              float dd[8] = {d0[0], d0[1], d0[2], d0[3], d1[0], d1[1], d1[2], d1[3]};
#pragma unroll
              for (int e = 0; e < 4; ++e) {
                v[2 * e] = gelu_t(v[2 * e] + lo16(pp[mm][e]) + dd[2 * e] * lo16(uu[mm][e]));
                v[2 * e + 1] = gelu_t(v[2 * e + 1] + hi16(pp[mm][e]) + dd[2 * e + 1] * hi16(uu[mm][e]));
              }
            }
            u32x4 o = {pk2(v[0], v[1]), pk2(v[2], v[3]), pk2(v[4], v[5]), pk2(v[6], v[7])};
            *(u32x4*)yp[mm] = o;
          }
          __builtin_amdgcn_sched_barrier(0);
        }
      }
  }
};
DEVI void s5_g2(KP P, int layer, int bid, int nblk, LAS unsigned char* lds) {
  {
    SchedS5C S{(const char*)P->ecar, (const char*)P->bg2, bid, nblk};
    EpiYg<false> E{P->z, P->ub, P->s_d + layer * 512};
    pg8::gemm_phase<true>(lds, S, E, 256);
  }
  {
    SchedS5U S{(const char*)P->ub, (const char*)P->bg2, 1536u, (size_t)512 * 768 * 2, 2, 256, bid, nblk};
    EpiYg<true> E{P->z, P->ub, P->s_d + layer * 512};
    pg8::gemm_phase<true>(lds, S, E, 512);
  }
}

struct EpiGlu {
  static constexpr bool CHAIN = false;
  u16* z; const float* gb;
  DEVI void operator()(const Acc8& acc, const pg8::Unit& u, int wr, int wc, int fr, int fq) const {
    const int row0 = u.pm * 256 + wr * 64 + fr, col0 = u.pn * 256 + wc * 32 + 8 * fq;
#pragma unroll
    for (int ai = 0; ai < 2; ++ai)
#pragma unroll
      for (int bj = 0; bj < 2; ++bj) {
        const int c = col0 + bj * 128;
        u32x4 yg[4], cg[4];
#pragma unroll
        for (int m = 0; m < 4; ++m) {
          u16* rowp = z + (unsigned)(row0 + ai * 128 + m * 16) * NZ;
          yg[m] = *(const u32x4*)(rowp + ZYG + c);
          cg[m] = *(const u32x4*)(rowp + ZC_G + c);
        }
        const f32x4 b0 = *(const f32x4*)(gb + c), b1 = *(const f32x4*)(gb + c + 4);
#pragma unroll
        for (int m = 0; m < 4; ++m) {
          u16* rowp = z + (unsigned)(row0 + ai * 128 + m * 16) * NZ;
          f32x4 v0 = acc[ai][bj][m][0] + b0, v1 = acc[ai][bj][m][1] + b1;
          float v[8] = {v0[0], v0[1], v0[2], v0[3], v1[0], v1[1], v1[2], v1[3]};
#pragma unroll
          for (int e = 0; e < 4; ++e) {
            v[2 * e] = lo16(yg[m][e]) * sigm(v[2 * e]) * silu(lo16(cg[m][e]));
            v[2 * e + 1] = hi16(yg[m][e]) * sigm(v[2 * e + 1]) * silu(hi16(cg[m][e]));
          }
          u32x4 o = {pk2(v[0], v[1]), pk2(v[2], v[3]), pk2(v[4], v[5]), pk2(v[6], v[7])};
          *(u32x4*)(rowp + ZC_G + c) = o;
        }
        __builtin_amdgcn_sched_barrier(0);
      }
  }
};
DEVI void ph_glu(KP P, int layer, int bid, int nblk, LAS unsigned char* lds) {
  pg8::SchedStd S{(const char*)(P->z + ZYG), (const char*)(P->wt_glu + (size_t)layer * 512 * 512), (unsigned)NZ * 2, 1024u, 128, 2, bid, nblk};
  EpiGlu E{P->z, P->glu_b + layer * 512};
  pg8::gemm_phase<true>(lds, S, E, 512);
}

struct SchedNB {
  const char* A; const char* B; unsigned lda2, ldb2; size_t b_nb; bool a_cols; int c, G;
  DEVI bool next(int i, pg8::Unit& u) const {
    if (i >= 8) return false;
    const int L = (i >> 2) * G + c;
    if (L >= 512) return false;
    pg8::tile_of(L, 128, 4, u.pm, u.pn); u.g = i & 3;
    return true;
  }
  DEVI const char* a_base(const pg8::Unit& u) const {
    const int gc = u.g == 0 ? ZA_G : u.g == 1 ? ZB_G : u.g == 2 ? ZC_G : ZD_G;
    return A + (a_cols ? gc * 2 : 0) + (size_t)u.pm * 256 * lda2;
  }
  DEVI const char* b_base(const pg8::Unit& u) const { return B + (size_t)u.g * b_nb + (size_t)u.pn * 256 * ldb2; }
  DEVI unsigned a_voff(int R, int C) const { return (unsigned)R * lda2 + C * 2; }
  DEVI unsigned b_voff(int R, int C) const { return (unsigned)R * ldb2 + C * 2; }
  DEVI size_t a_kstep() const { return 128; }
  DEVI size_t b_kstep() const { return 128; }
  DEVI size_t a_hstep() const { return (size_t)128 * lda2; }
  DEVI size_t b_hstep() const { return (size_t)128 * ldb2; }
};
DEVI u16* gate_row(u16* z, u16* ub, int nb, unsigned r) {
  return nb == 3 ? ub + r * 512u : z + (r * NZ + (nb == 0 ? 0 : nb == 1 ? 2048 : ZD_X));
}
struct EpiGateU8 {
  static constexpr bool CHAIN = false;
  u16* z; u16* ub;
  DEVI void operator()(const Acc8& acc, const pg8::Unit& u, int wr, int wc, int fr, int fq) const {
    const int row0 = u.pm * 256 + wr * 64 + fr, cl0 = wc * 32 + 8 * fq;
#pragma unroll
    for (int ai = 0; ai < 2; ++ai)
#pragma unroll
      for (int m = 0; m < 4; ++m) {
        const unsigned r = row0 + ai * 128 + m * 16;
        u16* gp = gate_row(z, ub, u.g, r) + u.pn * 128;
#pragma unroll
        for (int bj = 0; bj < 2; ++bj) {
          const int cl = cl0 + bj * 128;
          f32x4 v0 = acc[ai][bj][m][0], v1 = acc[ai][bj][m][1];
          uint2 o = {0u, 0u};
#pragma unroll
          for (int e = 0; e < 4; ++e) {
            o.x = __builtin_amdgcn_cvt_pk_u8_f32(fmaxf(sigm(v0[e]) * 255.f, 1.f), e, o.x);
            o.y = __builtin_amdgcn_cvt_pk_u8_f32(fmaxf(sigm(v1[e]) * 255.f, 1.f), e, o.y);
          }
          *(uint2*)(gp + (cl >> 1)) = o;
        }
      }
  }
};
struct EpiMergeChain {
  static constexpr bool CHAIN = true;
  u16* z; u16* ub;
  DEVI bool keep(const pg8::Unit& u) const { return u.g < 3; }
  DEVI void operator()(Acc8& acc, const pg8::Unit& u, int wr, int wc, int fr, int fq) const {
    const int row0 = u.pm * 256 + wr * 64 + fr, cl0 = wc * 32 + 8 * fq;
    const int nb = u.g, nbn = nb < 3 ? nb + 1 : 3;
#pragma unroll
    for (int ai = 0; ai < 2; ++ai)
#pragma unroll
      for (int bj = 0; bj < 2; ++bj) {
        const int cl = cl0 + bj * 128;
        uint2 ga[4], gb[4];
#pragma unroll
        for (int m = 0; m < 4; ++m) {
          const unsigned r = row0 + ai * 128 + m * 16;
          ga[m] = *(const uint2*)(gate_row(z, ub, nb, r) + u.pn * 128 + (cl >> 1));
          gb[m] = *(const uint2*)(gate_row(z, ub, nbn, r) + u.pn * 128 + (cl >> 1));
        }
#pragma unroll
        for (int m = 0; m < 4; ++m) {
          const unsigned r = row0 + ai * 128 + m * 16;
          float f[8];
#pragma unroll
          for (int e = 0; e < 4; ++e) {
            const float a0 = (float)((ga[m].x >> (8 * e)) & 255u), a1 = (float)((ga[m].y >> (8 * e)) & 255u);
            const float b0 = (float)((gb[m].x >> (8 * e)) & 255u), b1 = (float)((gb[m].y >> (8 * e)) & 255u);
            f[e] = nb < 3 ? a0 * __builtin_amdgcn_rcpf(b0) : a0 * (1.f / 255.f);
            f[4 + e] = nb < 3 ? a1 * __builtin_amdgcn_rcpf(b1) : a1 * (1.f / 255.f);
          }
          f32x4 v0 = acc[ai][bj][m][0], v1 = acc[ai][bj][m][1];
#pragma unroll
          for (int e = 0; e < 4; ++e) { v0[e] *= f[e]; v1[e] *= f[4 + e]; }
          acc[ai][bj][m][0] = v0;
          acc[ai][bj][m][1] = v1;
          if (nb == 3) {
            u32x4 o = {pk2(v0[0], v0[1]), pk2(v0[2], v0[3]), pk2(v1[0], v1[1]), pk2(v1[2], v1[3])};
            *(u32x4*)(z + (r * NZ + ZMRG + u.pn * 256 + cl)) = o;
          }
        }
        __builtin_amdgcn_sched_barrier(0);
      }
  }
};
DEVI void ph_merge(KP P, int layer, int bid, int nblk, LAS unsigned char* lds) {
  {
    SchedNB S{(const char*)P->hn, (const char*)(P->wt_in + ((size_t)layer * 9216 + 5120) * 1024), 2048u, 2048u, (size_t)1024 * 1024 * 2, false, bid, nblk};
    EpiGateU8 E{P->z, P->ub};
    pg8::gemm_phase<true>(lds, S, E, 1024);
  }
  {
    SchedNB S{(const char*)P->z, (const char*)(P->wt_br + (size_t)layer * 4 * 1024 * 512), (unsigned)NZ * 2, 1024u, (size_t)1024 * 512 * 2, true, bid, nblk};
    EpiMergeChain E{P->z, P->ub};
    pg8::gemm_phase<true>(lds, S, E, 512);
  }
}

struct EpiWout {
  static constexpr bool CHAIN = false;
  const float* xin; float* out; u16* hn;
  DEVI void operator()(const Acc8& acc, const pg8::Unit& u, int wr, int wc, int fr, int fq) const {
    const int row0 = u.pm * 256 + wr * 64 + fr, col0 = u.pn * 256 + wc * 32 + 4 * fq;
#pragma unroll
    for (int ai = 0; ai < 2; ++ai)
#pragma unroll
      for (int m = 0; m < 4; ++m) {
        const unsigned ro = (unsigned)(row0 + ai * 128 + m * 16) * 1024u;
        f32x4 xv[2][2];
#pragma unroll
        for (int bj = 0; bj < 2; ++bj)
#pragma unroll
          for (int n = 0; n < 2; ++n) xv[bj][n] = *(const f32x4*)(xin + (ro + col0 + bj * 128 + n * 16));
#pragma unroll
        for (int bj = 0; bj < 2; ++bj)
#pragma unroll
          for (int n = 0; n < 2; ++n) {
            const unsigned o = ro + col0 + bj * 128 + n * 16;
            f32x4 v = xv[bj][n] + acc[ai][bj][m][n];
            *(f32x4*)(out + o) = v;
            uint2 h = {pk2(v[0], v[1]), pk2(v[2], v[3])};
            *(uint2*)(hn + o) = h;
          }
        if (m & 1) __builtin_amdgcn_sched_barrier(0);
      }
  }
};
DEVI void ph_wout(KP P, int layer, int bid, int nblk, LAS unsigned char* lds) {
  pg8::SchedStd S{(const char*)(P->z + ZMRG), (const char*)(P->wt_out + (size_t)layer * 1024 * 1024), (unsigned)NZ * 2, 2048u, 128, 4, bid, nblk};
  EpiWout E{layer == 0 ? P->x : P->out, P->out, P->hn};
  pg8::gemm_phase<false>(lds, S, E, 1024);
  const float* pl = P->p + (size_t)layer * T * 256;
  for (int idx = bid * NT + tidx(); idx < T * 32; idx += nblk * NT) {
    int t = idx >> 5, c = (idx & 31) * 8;
    f32x4 a = *(const f32x4*)(pl + (size_t)t * 256 + c), b = *(const f32x4*)(pl + (size_t)t * 256 + c + 4);
    u32x4 o = {pk2(a[0], a[1]), pk2(a[2], a[3]), pk2(b[0], b[1]), pk2(b[2], b[3])};
    *(u32x4*)(P->z + (size_t)t * NZ + c) = o;
  }
}

struct EpiPle {
  static constexpr bool CHAIN = false;
  const u16* z; float* out;
  DEVI void operator()(const Acc8& acc, const pg8::Unit& u, int wr, int wc, int fr, int fq) const {
    const int row0 = u.pm * 256 + wr * 64 + fr, col0 = u.pn * 256 + wc * 32 + 8 * fq;
#pragma unroll
    for (int ai = 0; ai < 2; ++ai)
#pragma unroll
      for (int bj = 0; bj < 2; ++bj) {
        const int c = col0 + bj * 128;
        u32x4 pr[4];
        f32x4 x0[4], x1[4];
#pragma unroll
        for (int m = 0; m < 4; ++m) {
          const unsigned r = row0 + ai * 128 + m * 16;
          pr[m] = *(const u32x4*)(z + (r * NZ + ZMRG + c));
          x0[m] = *(const f32x4*)(out + (r * 1024u + c));
          x1[m] = *(const f32x4*)(out + (r * 1024u + c + 4));
        }
#pragma unroll
        for (int m = 0; m < 4; ++m) {
          const unsigned r = row0 + ai * 128 + m * 16;
          f32x4 v0 = acc[ai][bj][m][0], v1 = acc[ai][bj][m][1];
          f32x4 a = x0[m], bq = x1[m];
          a[0] += sigm(v0[0]) * lo16(pr[m][0]); a[1] += sigm(v0[1]) * hi16(pr[m][0]);
          a[2] += sigm(v0[2]) * lo16(pr[m][1]); a[3] += sigm(v0[3]) * hi16(pr[m][1]);
          bq[0] += sigm(v1[0]) * lo16(pr[m][2]); bq[1] += sigm(v1[1]) * hi16(pr[m][2]);
          bq[2] += sigm(v1[2]) * lo16(pr[m][3]); bq[3] += sigm(v1[3]) * hi16(pr[m][3]);
          *(f32x4*)(out + (r * 1024u + c)) = a;
          *(f32x4*)(out + (r * 1024u + c + 4)) = bq;
        }
        __builtin_amdgcn_sched_barrier(0);
      }
  }
};
DEVI void ph_ple(KP P, int layer, int bid, int nblk, LAS unsigned char* lds) {
  {
    pg8::SchedStd S{(const char*)P->z, (const char*)(P->wt_pp + (size_t)layer * 1024 * 256), (unsigned)NZ * 2, 512u, 128, 4, bid, nblk};
    EpiZ E{P->z + ZMRG, (unsigned)NZ};
    pg8::gemm_phase<true>(lds, S, E, 256);
  }
  {
    pg8::SchedStd S{(const char*)P->hn, (const char*)(P->wt_pg + (size_t)layer * 1024 * 1024), 2048u, 2048u, 128, 4, bid, nblk};
    EpiPle E{P->z, P->out};
    pg8::gemm_phase<true>(lds, S, E, 1024);
  }
}

DEVI void ph_mix1(KP P, int layer, int bid, int nblk, LAS unsigned char* lds) {
  s5_g1(P, bid, nblk, lds);
  ph_pool(P, layer, bid, nblk, lds);
  {
    LAS float* rpl = (LAS float*)lds;
    __syncthreads();
    for (int i = tidx(); i < 8 * 465; i += NT) rpl[i] = P->rpb[layer * 8 * 465 + i] * 1.4426950408889634f;
    __syncthreads();
    int t = tidx(), lane = t & 63, wave = t >> 6;
    LAS unsigned char* vb = lds + NA_VOFF + wave * (32 * NA_RS);
    if (wave < 4) {
      for (int u = bid * 8 + wave; u < 4096; u += nblk * 8) lru_unit<false>(P, layer, u, lane);
      for (int u = bid * 8 + wave; u < 16384; u += nblk * 8) na_unit(P, layer, u, lane, rpl, vb);
    } else {
      for (int u = bid * 8 + wave; u < 16384; u += nblk * 8) na_unit(P, layer, u, lane, rpl, vb);
      for (int u = bid * 8 + wave; u < 4096; u += nblk * 8) lru_unit<false>(P, layer, u, lane);
    }
  }
}
DEVI void ph_mix2(KP P, int layer, int bid, int nblk, LAS unsigned char* lds) {
  s5_g2(P, layer, bid, nblk, lds);
  int t = tidx(), lane = t & 63, wave = t >> 6;
  for (int u = bid * 8 + wave; u < 4096; u += nblk * 8) lru_unit<true>(P, layer, u, lane);
}


#define XB_TMO      128
#define XB_XCNT(j)  (256  + 64 * (j))
#define XB_XSUB(j)  (1280 + 64 * (j))
#define XB_XGEN(j)  (2304 + 64 * (j))
#define XB_TOP      3328
#define XB_TOPGEN   3392
#define XCD_BAR_WORDS 3456
#define XB_SPIN_CAP (1u << 18)
DEVI unsigned xb_ld(unsigned* p) { return __hip_atomic_load(p, __ATOMIC_RELAXED, __HIP_MEMORY_SCOPE_AGENT); }
DEVI unsigned xb_add(unsigned* p, unsigned v) { return __hip_atomic_fetch_add(p, v, __ATOMIC_RELAXED, __HIP_MEMORY_SCOPE_AGENT); }
DEVI unsigned xb_xcc_id() { return (unsigned)__builtin_amdgcn_s_getreg((3 << 11) | 20) & 0xFu; }
#define XB_SPIN(cond, bar) do { unsigned _sp = 0; while (cond) { __builtin_amdgcn_s_sleep(1); \
    if ((++_sp & 255u) == 0u) { if (xb_ld(&(bar)[XB_TMO])) break; if (_sp > XB_SPIN_CAP) { atomicAdd(&(bar)[XB_TMO], 1u); break; } } } } while (0)
DEVI void xcd_barrier_complete(unsigned* bar, unsigned x, unsigned& nloc, unsigned& nx) {
  const unsigned G = gridDim.x;
  unsigned sum, cnt, mine, sp = 0u;
  for (;;) {
    sum = 0u; cnt = 0u; mine = 0u;
#pragma unroll
    for (unsigned j = 0; j < 16; ++j) { const unsigned c = xb_ld(&bar[XB_XCNT(j)]); sum += c; cnt += (c > 0u) ? 1u : 0u; mine = (j == x) ? c : mine; }
    if (sum == G) break;
    __builtin_amdgcn_s_sleep(1);
    if ((++sp & 255u) == 0u) { if (xb_ld(&bar[XB_TMO])) break; if (sp > XB_SPIN_CAP) { atomicAdd(&bar[XB_TMO], 1u); break; } }
  }
  nloc = mine > 0u ? mine : 1u; nx = cnt > 0u ? cnt : 1u;
}
DEVI void xcd_barrier(unsigned* bar, volatile LAS unsigned* st) {
  asm volatile("s_waitcnt vmcnt(0)" ::: "memory");
  __syncthreads();
  if (threadIdx.x == 0) {
    const unsigned x = xb_xcc_id();
    __builtin_amdgcn_s_waitcnt(0);
    unsigned nloc = st[0], nx = st[1];
    if (nloc == 0u) { xcd_barrier_complete(bar, x, nloc, nx); st[0] = nloc; st[1] = nx; }
    const unsigned old = xb_add(&bar[XB_XSUB(x)], 1u);
    const unsigned gen = old / nloc;
    if (old + 1u == (gen + 1u) * nloc) {
      __builtin_amdgcn_fence(__ATOMIC_RELEASE, "agent");
      asm volatile("s_waitcnt vmcnt(0)" ::: "memory");
      const unsigned og = xb_add(&bar[XB_TOP], 1u);
      const unsigned tg = og / nx;
      if (og + 1u == (tg + 1u) * nx) xb_add(&bar[XB_TOPGEN], 1u);
      else XB_SPIN(xb_ld(&bar[XB_TOPGEN]) == tg, bar);
      __builtin_amdgcn_fence(__ATOMIC_ACQUIRE, "agent");
      xb_add(&bar[XB_XGEN(x)], 1u);
      asm volatile("s_waitcnt vmcnt(0)" ::: "memory");
    } else {
      XB_SPIN(xb_ld(&bar[XB_XGEN(x)]) == gen, bar);
      __builtin_amdgcn_fence(__ATOMIC_ACQUIRE, "agent");
      asm volatile("s_waitcnt vmcnt(0)" ::: "memory");
    }
  }
  __syncthreads();
}

constexpr int NPH = 18;
#ifndef PHMASK
#define PHMASK 0x1ff
#endif
template <int PH>
DEVI void run_ph(LAS unsigned char* lds, unsigned char* shm) {
  constexpr int layer = PH / 9, s = PH % 9;
  int bid = blockIdx.x, nblk = gridDim.x;
  KP P = getP();
  if constexpr (s == 0 && (PHMASK & 1)) {
    if (layer == 0) ph_wprep(P, bid, nblk, reinterpret_cast<float(*)[65]>(shm));
    ph_s5pre1(P, layer, bid, nblk, lds);
    ph_rmsnorm(P, layer, bid, nblk);
  }
  if constexpr (s == 1 && (PHMASK & 2)) {
    ph_s5pre2(P, bid, nblk);
    ph_gemm1(P, layer, bid, nblk, lds);
  }
  if constexpr (s == 2 && (PHMASK & 4)) ph_mix1(P, layer, bid, nblk, lds);
  if constexpr (s == 3 && (PHMASK & 8)) {
    ph_lru_carry(P, bid, nblk);
    ph_s5_carry(P, layer, bid, nblk);
  }
  if constexpr (s == 4 && (PHMASK & 16)) ph_mix2(P, layer, bid, nblk, lds);
  if constexpr (s == 5 && (PHMASK & 32)) ph_glu(P, layer, bid, nblk, lds);
  if constexpr (s == 6 && (PHMASK & 64)) ph_merge(P, layer, bid, nblk, lds);
  if constexpr (s == 7 && (PHMASK & 128)) ph_wout(P, layer, bid, nblk, lds);
  if constexpr (s == 8 && (PHMASK & 256)) ph_ple(P, layer, bid, nblk, lds);
}
__global__ void __launch_bounds__(512) mega(Params P_unused) {
  extern __shared__ __attribute__((aligned(16))) unsigned char shm[];
  LAS unsigned char* lds = (LAS unsigned char*)shm;
  cg::grid_group grid = cg::this_grid();
  volatile LAS unsigned* st = (volatile LAS unsigned*)(lds + pg8::STAGE_BYTES);
  if (threadIdx.x == 0) {
    st[0] = 0u; st[1] = 0u;
    KP Pq = getP();
    (void)xb_add(&Pq->bar[XB_XCNT(xb_xcc_id())], 1u);
  }
  __syncthreads();
#define RP(n) run_ph<n>(lds, shm)
#define GS() do { KP Pq = getP(); xcd_barrier(Pq->bar, st); } while (0)
  if (gridDim.x == 0x7fffffffu) grid.sync();
  RP(0); GS(); RP(1); GS(); RP(2); GS(); RP(3); GS(); RP(4); GS(); RP(5); GS();
  RP(6); GS(); RP(7); GS(); RP(8); GS();
  RP(9); GS(); RP(10); GS(); RP(11); GS(); RP(12); GS(); RP(13); GS(); RP(14); GS();
  RP(15); GS(); RP(16); GS(); RP(17);
#undef RP
#undef GS
}

extern "C" void kernel_launch(void* const* d_in, const int* in_sizes, int n_in, void* d_out, int out_size, void* d_ws,
                              size_t ws_size, hipStream_t stream) {
  Params P{};
  const float** pf = reinterpret_cast<const float**>(&P);
  for (int i = 0; i < 30; ++i) pf[i] = (const float*)d_in[i];
  P.out = (float*)d_out;
  char* w = (char*)d_ws;
  size_t off = 0;
  auto take = [&](size_t bytes) {
    char* r = w + off;
    off += (bytes + 255) & ~(size_t)255;
    return r;
  };
  P.wt_in = (u16*)take((size_t)2 * 9216 * 1024 * 2);
  P.wt_br = (u16*)take((size_t)8 * 1024 * 512 * 2);
  P.wt_out = (u16*)take((size_t)2 * 1024 * 1024 * 2);
  P.wt_pg = (u16*)take((size_t)2 * 1024 * 1024 * 2);
  P.wt_pp = (u16*)take((size_t)2 * 1024 * 256 * 2);
  P.wt_glu = (u16*)take((size_t)2 * 512 * 512 * 2);
  P.wt_pool = (u16*)take((size_t)8 * 128 * 128 * 2);
  P.wt_lr = (u16*)take((size_t)32 * 64 * 64 * 2);
  P.wt_li = (u16*)take((size_t)32 * 64 * 64 * 2);
  P.hn = (u16*)take((size_t)T * 1024 * 2);
  P.z = (u16*)take((size_t)T * NZ * 2);
  P.ub = (u16*)take((size_t)T * 512 * 2);
  P.w1 = (u16*)take((size_t)32 * 256 * 512 * 2);
  P.bg2 = (u16*)take((size_t)32 * 512 * 768 * 2);
  P.ecar = (u16*)take((size_t)32 * 1024 * 256 * 2);
  P.ktab = (float*)take((size_t)32 * 2 * 32 * 256 * 4);
  P.lagg = (float*)take((size_t)8 * 64 * 2 * 512 * 2 * 4);
  P.lcar = (float*)take((size_t)8 * 64 * 2 * 512 * 4);
  P.bar = (unsigned*)take((size_t)XCD_BAR_WORDS * 4);
  if (off > ws_size) {
    fprintf(stderr, "workspace too small: need %zu have %zu\n", off, ws_size);
    return;
  }
  static int grid_blocks = 0;
  if (!grid_blocks) {
    int dev = 0, cus = 0, per_cu = 0;
    (void)hipGetDevice(&dev);
    (void)hipDeviceGetAttribute(&cus, hipDeviceAttributeMultiprocessorCount, dev);
    (void)hipFuncSetAttribute((const void*)mega, hipFuncAttributeMaxDynamicSharedMemorySize, pg8::STAGE_BYTES + 16);
    (void)hipOccupancyMaxActiveBlocksPerMultiprocessor(&per_cu, mega, NT, pg8::STAGE_BYTES + 16);
    if (per_cu > 1) per_cu = 1;
    grid_blocks = cus * per_cu;
  }
  void* args[] = {&P};
  (void)hipMemsetAsync(P.bar, 0, (size_t)XCD_BAR_WORDS * 4, stream);
  hipError_t e = hipLaunchCooperativeKernel((void*)mega, dim3(grid_blocks), dim3(NT), args, pg8::STAGE_BYTES + 16, stream);
  if (e != hipSuccess) fprintf(stderr, "cooperative launch failed: %s (grid %d)\n", hipGetErrorString(e), grid_blocks);
}
```

```cpp
#include <hip/hip_runtime.h>
#include <hip/hip_cooperative_groups.h>
#include <cstdio>
namespace cg = cooperative_groups;

typedef __attribute__((ext_vector_type(8))) short bf16x8;
typedef __attribute__((ext_vector_type(4))) float f32x4;
typedef unsigned short u16;
#define DEVI __device__ __forceinline__

constexpr int T = 32768, NZ = 4608;
constexpr int ZA_X = 0, ZA_G = 512, ZQ = 1024, ZK = 1536, ZV = 2048, ZB_G = 2560, ZC_G = 3072,
              ZD_X = 3584, ZD_G = 4096, ZMRG = 1024, ZYG = 2048;

struct Params {
  const float *x, *p, *norm_scale, *w_in, *conv_w, *conv_b, *w_r, *b_r, *w_i, *b_i, *lam, *q_gain, *k_gain, *rpb,
      *a_re, *a_im, *log_dt, *sb_re, *sb_im, *sc_re, *sc_im, *s_d, *glu_w, *glu_b, *pool_w, *pool_scale, *w_branch,
      *w_out, *ple_proj, *ple_gate;
  float* out;
  u16 *wt_in, *wt_br, *wt_out, *wt_pg, *wt_pp, *wt_glu, *wt_pool, *wt_lr, *wt_li, *hn, *z, *w1, *bg2, *ecar, *ub;
  float *ktab, *lagg, *lcar;
  unsigned* bar;
};

typedef const Params __attribute__((address_space(4)))* KP;
__device__ __forceinline__ KP getP() {
  unsigned long long a = (unsigned long long)__builtin_amdgcn_kernarg_segment_ptr();
  unsigned lo = (unsigned)a, hi = (unsigned)(a >> 32);
  asm volatile("" : "+v"(lo), "+v"(hi));
  lo = __builtin_amdgcn_readfirstlane(lo);
  hi = __builtin_amdgcn_readfirstlane(hi);
  return (KP)(((unsigned long long)hi << 32) | lo);
}
DEVI int tidx() {
  int t = threadIdx.x;
  asm volatile("" : "+v"(t));
  return t;
}
DEVI unsigned pk2(float lo, float hi) {
  unsigned r;
  asm("v_cvt_pk_bf16_f32 %0, %1, %2" : "=v"(r) : "v"(lo), "v"(hi));
  return r;
}
DEVI u16 f2bf(float f) { return (u16)(pk2(f, f) & 0xffffu); }
DEVI float bf2f(u16 h) { return __uint_as_float(((unsigned)h) << 16); }
DEVI float bfs(short h) { return __uint_as_float(((unsigned)(u16)h) << 16); }
DEVI bf16x8 ld8(const u16* p) { return *reinterpret_cast<const bf16x8*>(p); }
DEVI float sigm(float x) { return __builtin_amdgcn_rcpf(1.f + __expf(-x)); }
DEVI float silu(float x) { return x * __builtin_amdgcn_rcpf(1.f + __expf(-x)); }
DEVI float gelu_t(float x) {
  float u = 0.7978845608028654f * (x + 0.044715f * x * x * x);
  float t = 1.f - 2.f * __builtin_amdgcn_rcpf(1.f + __expf(2.f * u));
  return 0.5f * x * (1.f + t);
}
typedef unsigned u32x4_t __attribute__((ext_vector_type(4)));
DEVI bf16x8 pack8(const float* v) {
  u32x4_t r = {pk2(v[0], v[1]), pk2(v[2], v[3]), pk2(v[4], v[5]), pk2(v[6], v[7])};
  return __builtin_bit_cast(bf16x8, r);
}
DEVI f32x4 mfma(bf16x8 a, bf16x8 b, f32x4 c) { return __builtin_amdgcn_mfma_f32_16x16x32_bf16(a, b, c, 0, 0, 0); }


#define LAS __attribute__((address_space(3)))
constexpr int NT = 512;
namespace pg8 {
constexpr int BM = 256, BK = 64, HALF = 128, HTB = HALF * BK * 2, STAGE_BYTES = 8 * HTB, NXCD = 8, WGM = 8;
DEVI int lds_byte(int r, int c) {
  const int st = (r >> 4) * 2 + (c >> 5), rr = r & 15, cc = c & 31, ob = rr * 64 + cc * 2;
  return st * 1024 + (ob ^ (((ob >> 9) & 1) << 5));
}
DEVI void stage_rc(int b, int& R, int& C) {
  const int st = b / 1024, sb = b % 1024, swz = sb ^ (((sb >> 9) & 1) << 5);
  R = (st >> 1) * 16 + swz / 64;
  C = (st & 1) * 32 + (swz % 64) / 2;
}
DEVI int perm32(int rho) { const int n = rho >> 4, i = rho & 15; return 8 * (i >> 2) + 4 * n + (i & 3); }
struct Unit { int pm, pn, g; };
DEVI void tile_of(int L, int nM, int nN, int& pm, int& pn) {
  const int nwg = nM * nN;
  int wgid = L;
  { const int q = nwg / NXCD, r = nwg % NXCD, xcd = wgid % NXCD, off = wgid / NXCD; wgid = (xcd < r ? xcd * (q + 1) : r * (q + 1) + (xcd - r) * q) + off; }
  const int nig = WGM * nN, gid = wgid / nig, fm = gid * WGM, gsz = (nM - fm) < WGM ? (nM - fm) : WGM;
  pm = fm + ((wgid % nig) % gsz);
  pn = (wgid % nig) / gsz;
}
struct SchedStd {
  const char* A; const char* B; unsigned lda2, ldb2; int nM, nN, c, G;
  DEVI bool next(int i, Unit& u) const {
    const int L = i * G + c;
    if (L >= nM * nN) return false;
    tile_of(L, nM, nN, u.pm, u.pn); u.g = 0;
    return true;
  }
  DEVI const char* a_base(const Unit& u) const { return A + (size_t)u.pm * 256 * lda2; }
  DEVI const char* b_base(const Unit& u) const { return B + (size_t)u.pn * 256 * ldb2; }
  DEVI unsigned a_voff(int R, int C) const { return (unsigned)R * lda2 + C * 2; }
  DEVI unsigned b_voff(int R, int C) const { return (unsigned)R * ldb2 + C * 2; }
  DEVI size_t a_kstep() const { return 128; }
  DEVI size_t b_kstep() const { return 128; }
  DEVI size_t a_hstep() const { return (size_t)128 * lda2; }
  DEVI size_t b_hstep() const { return (size_t)128 * ldb2; }
};

template <bool PERM, class Sched, class Epi>
DEVI void gemm_phase(LAS unsigned char* lds, const Sched& S, const Epi& E, const int K) {
  int tid_ = tidx();
  const int tid = tid_, wid = __builtin_amdgcn_readfirstlane(tid >> 6), lane = tid & 63, wr = wid >> 2, wc = wid & 3, fr = lane & 15, fq = lane >> 4;
  const int nt = K / BK;
  unsigned voffA[2], voffB[2];
#pragma unroll
  for (int i = 0; i < 2; ++i) {
    int R, C;
    stage_rc(tid * 16 + i * 8192, R, C);
    const int Rb = PERM ? ((R & ~31) + perm32(R & 31)) : R;
    voffA[i] = S.a_voff(R, C);
    voffB[i] = S.b_voff(Rb, C);
  }
  const size_t kA = S.a_kstep(), kB = S.b_kstep(), hA = S.a_hstep(), hB = S.b_hstep();
  const unsigned ldsw = (unsigned)wid * 1024u;
  const int aoff = lds_byte(wr * 64 + fr, fq * 8), boff = lds_byte(wc * 32 + fr, fq * 8);
#define PG8_SA(b, h) (((b) * 2 + (h)) * HTB)
#define PG8_SB(b, h) ((4 + (b) * 2 + (h)) * HTB)
#define PG8_STAGE(bufoff, gbase, voff) do { _Pragma("unroll") for (int _i = 0; _i < 2; ++_i) \
    __builtin_amdgcn_global_load_lds((const unsigned*)((const char*)(gbase) + (voff)[_i]), (LAS unsigned*)(lds + (bufoff) + ldsw + _i * 8192), 16, 0, 0); } while (0)
#define PG8_LDA(dst, b, h) do { _Pragma("unroll") for (int m = 0; m < 4; ++m) _Pragma("unroll") for (int k = 0; k < 2; ++k) dst[m][k] = *(const LAS bf16x8*)(lds + PG8_SA(b, h) + aoff + m * 2048 + k * 1024); } while (0)
#define PG8_LDB(dst, b, h) do { _Pragma("unroll") for (int n = 0; n < 2; ++n) _Pragma("unroll") for (int k = 0; k < 2; ++k) dst[n][k] = *(const LAS bf16x8*)(lds + PG8_SB(b, h) + boff + n * 2048 + k * 1024); } while (0)
#define PG8_MMA(ai, bj, At, Bt) do { __builtin_amdgcn_s_setprio(1); _Pragma("unroll") for (int m = 0; m < 4; ++m) _Pragma("unroll") for (int n = 0; n < 2; ++n) _Pragma("unroll") for (int k = 0; k < 2; ++k) \
    acc[ai][bj][m][n] = __builtin_amdgcn_mfma_f32_16x16x32_bf16(Bt[n][k], At[m][k], acc[ai][bj][m][n], 0, 0, 0); __builtin_amdgcn_s_setprio(0); } while (0)
#define PG8_WAIT_V(n) asm volatile("s_waitcnt vmcnt(" #n ")" ::: "memory")
#define PG8_WAIT_L(n) asm volatile("s_waitcnt lgkmcnt(" #n ")" ::: "memory")
#define PG8_BAR __builtin_amdgcn_s_barrier()
#define PG8_SCHED __builtin_amdgcn_sched_barrier(0)
  Unit cur, nxt;
  int ui = 0;
  if (!S.next(0, cur)) return;
  f32x4 acc[2][2][4][2];
#pragma unroll
  for (int a = 0; a < 2; ++a)
#pragma unroll
    for (int b = 0; b < 2; ++b)
#pragma unroll
      for (int m = 0; m < 4; ++m)
#pragma unroll
        for (int n = 0; n < 2; ++n) acc[a][b][m][n] = (f32x4){0.f, 0.f, 0.f, 0.f};
  bf16x8 At[4][2], B0[2][2], B1[2][2];
  const char* cA = S.a_base(cur);
  const char* cB = S.b_base(cur);
  PG8_STAGE(PG8_SB(0, 0), cB, voffB); PG8_STAGE(PG8_SA(0, 0), cA, voffA); PG8_STAGE(PG8_SB(0, 1), cB + hB, voffB); PG8_STAGE(PG8_SA(0, 1), cA + hA, voffA);
  if (wr == 1) PG8_BAR;
  PG8_WAIT_V(4); PG8_BAR;
  PG8_STAGE(PG8_SB(1, 0), cB + kB, voffB); PG8_STAGE(PG8_SA(1, 0), cA + kA, voffA); PG8_STAGE(PG8_SB(1, 1), cB + hB + kB, voffB);
  PG8_WAIT_V(6); PG8_BAR;
  for (;;) {
    const bool has_next = S.next(ui + 1, nxt);
    const char* nA = has_next ? S.a_base(nxt) : cA;
    const char* nB = has_next ? S.b_base(nxt) : cB;
    for (int t = 0; t < nt; t += 2) {
      const bool last = (t == nt - 2);
      const char* a1 = cA + (size_t)(t + 1) * kA;
      const char* a2 = last ? nA : cA + (size_t)(t + 2) * kA;
      const char* b2 = last ? nB : cB + (size_t)(t + 2) * kB;
      const char* a3 = a2 + kA;
      const char* b3 = b2 + kB;
      PG8_LDB(B0, 0, 0); PG8_SCHED; PG8_LDA(At, 0, 0); PG8_STAGE(PG8_SA(1, 1), a1 + hA, voffA);
      PG8_WAIT_L(8); PG8_BAR; PG8_WAIT_L(0); PG8_MMA(0, 0, At, B0); PG8_BAR; PG8_SCHED;
      PG8_LDB(B1, 0, 1); PG8_STAGE(PG8_SB(0, 0), b2, voffB);
      PG8_BAR; PG8_WAIT_L(0); PG8_MMA(0, 1, At, B1); PG8_BAR;
      PG8_LDA(At, 0, 1); PG8_STAGE(PG8_SA(0, 0), a2, voffA);
      PG8_BAR; PG8_WAIT_L(0); PG8_MMA(1, 0, At, B0); PG8_BAR; PG8_SCHED;
      PG8_STAGE(PG8_SB(0, 1), b2 + hB, voffB);
      PG8_WAIT_V(6); PG8_BAR; PG8_MMA(1, 1, At, B1); PG8_BAR;
      PG8_LDB(B0, 1, 0); PG8_SCHED; PG8_LDA(At, 1, 0); PG8_STAGE(PG8_SA(0, 1), a2 + hA, voffA);
      PG8_WAIT_L(8); PG8_BAR; PG8_WAIT_L(0); PG8_MMA(0, 0, At, B0); PG8_BAR; PG8_SCHED;
      PG8_LDB(B1, 1, 1); PG8_STAGE(PG8_SB(1, 0), b3, voffB);
      PG8_BAR; PG8_WAIT_L(0); PG8_MMA(0, 1, At, B1); PG8_BAR;
      PG8_LDA(At, 1, 1); PG8_STAGE(PG8_SA(1, 0), a3, voffA);
      PG8_BAR; PG8_WAIT_L(0); PG8_MMA(1, 0, At, B0); PG8_BAR; PG8_SCHED;
      PG8_STAGE(PG8_SB(1, 1), b3 + hB, voffB);
      PG8_WAIT_V(6); PG8_BAR; PG8_MMA(1, 1, At, B1); PG8_BAR;
    }
    { const int l2 = tidx() & 63; E(acc, cur, wr, wc, l2 & 15, l2 >> 4); }
    if (!has_next) break;
    bool keep = false;
    if constexpr (Epi::CHAIN) keep = E.keep(cur);
    if (!keep)
#pragma unroll
    for (int a = 0; a < 2; ++a)
#pragma unroll
      for (int b = 0; b < 2; ++b)
#pragma unroll
        for (int m = 0; m < 4; ++m)
#pragma unroll
          for (int n = 0; n < 2; ++n) acc[a][b][m][n] = (f32x4){0.f, 0.f, 0.f, 0.f};
    cur = nxt; cA = nA; cB = nB; ++ui;
  }
  PG8_WAIT_V(0);
  if (wr == 0) PG8_BAR;
  PG8_BAR;
#undef PG8_SA
#undef PG8_SB
#undef PG8_STAGE
#undef PG8_LDA
#undef PG8_LDB
#undef PG8_MMA
#undef PG8_WAIT_V
#undef PG8_WAIT_L
#undef PG8_BAR
#undef PG8_SCHED
}
}
typedef f32x4 Acc8[2][2][4][2];
typedef unsigned u32x4 __attribute__((ext_vector_type(4)));
DEVI float lo16(unsigned v) { return __uint_as_float(v << 16); }
DEVI float hi16(unsigned v) { return __uint_as_float(v & 0xffff0000u); }

template <class AF, class BF>
DEVI void mma_loop(f32x4 (&acc)[4][4], int K, AF af, BF bf) {
  for (int k0 = 0; k0 < K; k0 += 32) {
    bf16x8 a[4], b[4];
#pragma unroll
    for (int i = 0; i < 4; ++i) a[i] = af(i, k0);
#pragma unroll
    for (int i = 0; i < 4; ++i) b[i] = bf(i, k0);
#pragma unroll
    for (int i = 0; i < 4; ++i)
#pragma unroll
      for (int j = 0; j < 4; ++j) acc[i][j] = mfma(a[i], b[j], acc[i][j]);
  }
}
DEVI void zero_acc(f32x4 (&acc)[4][4]) {
#pragma unroll
  for (int i = 0; i < 4; ++i)
#pragma unroll
    for (int j = 0; j < 4; ++j) acc[i][j] = f32x4{0.f, 0.f, 0.f, 0.f};
}

DEVI void tconv(const float* src, u16* dst, int nb, int K, int N, int bid, int nblk, float (*tile)[65]) {
  int tx = tidx() & 63, ty = tidx() >> 6;
  int tk = K / 64, tn = N / 64, nt = nb * tk * tn;
  for (int t = bid; t < nt; t += nblk) {
    int mb = t / (tk * tn), r = t % (tk * tn), k0 = (r / tn) * 64, n0 = (r % tn) * 64;
#pragma unroll
    for (int i = 0; i < 8; ++i) tile[ty + 8 * i][tx] = src[((size_t)mb * K + k0 + ty + 8 * i) * N + n0 + tx];
    __syncthreads();
#pragma unroll
    for (int i = 0; i < 8; ++i) dst[((size_t)mb * N + n0 + ty + 8 * i) * K + k0 + tx] = f2bf(tile[tx][ty + 8 * i]);
    __syncthreads();
  }
}

DEVI void ph_wprep(KP P, int bid, int nblk, float (*tile)[65]) {
  tconv(P->w_in, P->wt_in, 2, 1024, 9216, bid, nblk, tile);
  tconv(P->w_branch, P->wt_br, 8, 512, 1024, bid, nblk, tile);
  tconv(P->w_out, P->wt_out, 2, 1024, 1024, bid, nblk, tile);
  tconv(P->ple_gate, P->wt_pg, 2, 1024, 1024, bid, nblk, tile);
  tconv(P->ple_proj, P->wt_pp, 2, 256, 1024, bid, nblk, tile);
  tconv(P->glu_w, P->wt_glu, 2, 512, 512, bid, nblk, tile);
  tconv(P->pool_w, P->wt_pool, 8, 128, 128, bid, nblk, tile);
  tconv(P->w_r, P->wt_lr, 32, 64, 64, bid, nblk, tile);
  tconv(P->w_i, P->wt_li, 32, 64, 64, bid, nblk, tile);
}

DEVI void ph_rmsnorm(KP P, int layer, int bid, int nblk) {
  int lane = tidx() & 63, wave = tidx() >> 6;
  const float* xin = layer == 0 ? P->x : P->out;
  const float4* g4 = reinterpret_cast<const float4*>(P->norm_scale + layer * 1024);
  for (int t = bid * 8 + wave; t < T; t += nblk * 8) {
    const float4* x4 = reinterpret_cast<const float4*>(xin + (size_t)t * 1024);
    float4 v[4];
    float ss = 0.f;
#pragma unroll
    for (int i = 0; i < 4; ++i) {
      v[i] = x4[lane + 64 * i];
      ss += v[i].x * v[i].x + v[i].y * v[i].y + v[i].z * v[i].z + v[i].w * v[i].w;
    }
#pragma unroll
    for (int o = 32; o >= 1; o >>= 1) ss += __shfl_xor(ss, o);
    float rinv = rsqrtf(ss * (1.f / 1024.f) + 1e-6f);
#pragma unroll
    for (int i = 0; i < 4; ++i) {
      float4 g = g4[lane + 64 * i];
      uint2 o;
      o.x = pk2(v[i].x * rinv * g.x, v[i].y * rinv * g.y);
      o.y = pk2(v[i].z * rinv * g.z, v[i].w * rinv * g.w);
      *reinterpret_cast<uint2*>(P->hn + (size_t)t * 1024 + (lane + 64 * i) * 4) = o;
    }
  }
}

struct CP { float lr, li, dt, fr, fi; };
DEVI void sincos_rev(float x, float& sn, float& cs) {
  float rev = x * 0.15915494309189535f;
  rev -= rintf(rev);
  sn = __builtin_amdgcn_sinf(rev);
  cs = __builtin_amdgcn_cosf(rev);
}
DEVI CP s5p(KP P, int layer, int d, int g, int p) {
  int i1 = (layer * 2 + d) * 32 + g;
  CP c;
  c.lr = fminf(P->a_re[i1 * 64 + p], -1e-4f);
  c.li = P->a_im[i1 * 64 + p];
  c.dt = expf(P->log_dt[i1]);
  float mag = expf(c.lr * c.dt), sn = sinf(c.li * c.dt), cs = cosf(c.li * c.dt);
  float abr = mag * cs, abi = mag * sn, nr = abr - 1.f, den = c.lr * c.lr + c.li * c.li;
  c.fr = (nr * c.lr + abi * c.li) / den;
  c.fi = (abi * c.lr - nr * c.li) / den;
  return c;
}
DEVI void cpow(const CP& c, float e, float& pr, float& pi) {
  float m = expf(e * c.lr * c.dt), sn, cs;
  sincos_rev(e * c.li * c.dt, sn, cs);
  pr = m * cs;
  pi = m * sn;
}

DEVI void ph_s5pre1(KP P, int layer, int bid, int nblk, LAS unsigned char* lds) {
  int gtid = bid * NT + tidx(), gstride = nblk * NT;
  LAS float* cps = (LAS float*)lds;
  for (int idx = gtid; idx < 32 * 2 * 32 * 16; idx += gstride) {
    int co = idx & 15, tau = (idx >> 4) & 31, d = (idx >> 9) & 1, g = idx >> 10;
    int i1 = (layer * 2 + d) * 32 + g;
    __syncthreads();
    if (tidx() < 64) {
      CP c0 = s5p(P, layer, d, g, tidx());
      LAS float* o = cps + tidx() * 5;
      o[0] = c0.lr; o[1] = c0.li; o[2] = c0.dt; o[3] = c0.fr; o[4] = c0.fi;
    }
    __syncthreads();
    float acc[16];
#pragma unroll
    for (int i = 0; i < 16; ++i) acc[i] = 0.f;
    for (int p = 0; p < 64; ++p) {
      CP c;
      c.lr = cps[p * 5]; c.li = cps[p * 5 + 1]; c.dt = cps[p * 5 + 2]; c.fr = cps[p * 5 + 3]; c.fi = cps[p * 5 + 4];
      float pr, pi;
      cpow(c, (float)tau, pr, pi);
      float cr = P->sc_re[((size_t)i1 * 16 + co) * 64 + p], ci = P->sc_im[((size_t)i1 * 16 + co) * 64 + p];
      float g1r = cr * pr - ci * pi, g1i = cr * pi + ci * pr;
      float gr = g1r * c.fr - g1i * c.fi, gi = g1r * c.fi + g1i * c.fr;
      const float* br = P->sb_re + ((size_t)i1 * 64 + p) * 16;
      const float* bi = P->sb_im + ((size_t)i1 * 64 + p) * 16;
#pragma unroll
      for (int i = 0; i < 16; ++i) acc[i] += gr * br[i] - gi * bi[i];
    }
    float* o = P->ktab + (size_t)idx * 16;
#pragma unroll
    for (int i = 0; i < 16; ++i) o[i] = acc[i];
  }
  for (int idx = gtid; idx < 32 * 2 * 64 * 32; idx += gstride) {
    int i = idx & 31, p = (idx >> 5) & 63, d = (idx >> 11) & 1, g = idx >> 12;
    int i1 = (layer * 2 + d) * 32 + g;
    CP c = s5p(P, layer, d, g, p);
    float pr, pi;
    cpow(c, d == 0 ? (float)(31 - i) : (float)i, pr, pi);
    float qr = pr * c.fr - pi * c.fi, qi = pr * c.fi + pi * c.fr;
    const float* br = P->sb_re + ((size_t)i1 * 64 + p) * 16;
    const float* bi = P->sb_im + ((size_t)i1 * 64 + p) * 16;
    u16* ore = P->w1 + ((size_t)g * 256 + d * 128 + p) * 512 + i * 16;
    u16* oim = ore + (size_t)64 * 512;
    float vr[16], vi[16];
#pragma unroll
    for (int ci = 0; ci < 16; ++ci) {
      vr[ci] = qr * br[ci] - qi * bi[ci];
      vi[ci] = qr * bi[ci] + qi * br[ci];
    }
#pragma unroll
    for (int h = 0; h < 2; ++h) {
      *(u32x4_t*)(ore + 8 * h) = (u32x4_t){pk2(vr[8 * h], vr[8 * h + 1]), pk2(vr[8 * h + 2], vr[8 * h + 3]), pk2(vr[8 * h + 4], vr[8 * h + 5]), pk2(vr[8 * h + 6], vr[8 * h + 7])};
      *(u32x4_t*)(oim + 8 * h) = (u32x4_t){pk2(vi[8 * h], vi[8 * h + 1]), pk2(vi[8 * h + 2], vi[8 * h + 3]), pk2(vi[8 * h + 4], vi[8 * h + 5]), pk2(vi[8 * h + 6], vi[8 * h + 7])};
    }
  }
  for (int idx = gtid; idx < 32 * 2 * 32 * 64; idx += gstride) {
    int p = idx & 63, j = (idx >> 6) & 31, d = (idx >> 11) & 1, g = idx >> 12;
    int i1 = (layer * 2 + d) * 32 + g;
    CP c = s5p(P, layer, d, g, p);
    float pr, pi;
    cpow(c, d == 0 ? (float)(j + 1) : (float)(32 - j), pr, pi);
    for (int co = 0; co < 16; ++co) {
      float cr = P->sc_re[((size_t)i1 * 16 + co) * 64 + p], ci = P->sc_im[((size_t)i1 * 16 + co) * 64 + p];
      float gr = cr * pr - ci * pi, gi = cr * pi + ci * pr;
      u16* o = P->bg2 + ((size_t)g * 512 + j * 16 + co) * 768 + 512 + d * 128 + p;
      o[0] = f2bf(gr);
      o[64] = f2bf(-gi);
    }
  }
}
DEVI void ph_s5pre2(KP P, int bid, int nblk) {
  int gtid = bid * NT + tidx(), gstride = nblk * NT;
  for (int idx = gtid; idx < 32 * 32 * 16 * 32; idx += gstride) {
    int i = idx & 31, co = (idx >> 5) & 15, j = (idx >> 9) & 31, g = idx >> 14;
    float v[16];
#pragma unroll
    for (int ci = 0; ci < 16; ++ci) v[ci] = 0.f;
    if (i <= j) {
      const float* k = P->ktab + ((((size_t)g * 2 + 0) * 32 + (j - i)) * 16 + co) * 16;
#pragma unroll
      for (int ci = 0; ci < 16; ++ci) v[ci] += k[ci];
    }
    if (i >= j) {
      const float* k = P->ktab + ((((size_t)g * 2 + 1) * 32 + (i - j)) * 16 + co) * 16;
#pragma unroll
      for (int ci = 0; ci < 16; ++ci) v[ci] += k[ci];
    }
    u16* o = P->bg2 + ((size_t)g * 512 + j * 16 + co) * 768 + i * 16;
#pragma unroll
    for (int h = 0; h < 2; ++h)
      *(u32x4_t*)(o + 8 * h) = (u32x4_t){pk2(v[8 * h], v[8 * h + 1]), pk2(v[8 * h + 2], v[8 * h + 3]), pk2(v[8 * h + 4], v[8 * h + 5]), pk2(v[8 * h + 6], v[8 * h + 7])};
  }
}

struct EpiZ {
  static constexpr bool CHAIN = false;
  u16* O; unsigned ldo;
  DEVI void operator()(const Acc8& acc, const pg8::Unit& u, int wr, int wc, int fr, int fq) const {
    const int row0 = u.pm * 256 + wr * 64 + fr, col0 = u.pn * 256 + wc * 32 + 8 * fq;
#pragma unroll
    for (int ai = 0; ai < 2; ++ai)
#pragma unroll
      for (int m = 0; m < 4; ++m) {
        u16* rowp = O + (size_t)(row0 + ai * 128 + m * 16) * ldo + col0;
#pragma unroll
        for (int bj = 0; bj < 2; ++bj) {
          f32x4 v0 = acc[ai][bj][m][0], v1 = acc[ai][bj][m][1];
          u32x4 o = {pk2(v0[0], v0[1]), pk2(v0[2], v0[3]), pk2(v1[0], v1[1]), pk2(v1[2], v1[3])};
          *(u32x4*)(rowp + bj * 128) = o;
        }
      }
  }
};
struct EpiZ1 {
  static constexpr bool CHAIN = false;
  u16* z; u16* ub;
  DEVI void operator()(const Acc8& acc, const pg8::Unit& u, int wr, int wc, int fr, int fq) const {
    const int row0 = u.pm * 256 + wr * 64 + fr, cl0 = wc * 32 + 8 * fq;
    const bool cx = (u.pn == 12 || u.pn == 13);
    const int zc = u.pn * 256 - (u.pn >= 14 ? 512 : 0);
#pragma unroll
    for (int ai = 0; ai < 2; ++ai)
#pragma unroll
      for (int m = 0; m < 4; ++m) {
        const unsigned r = row0 + ai * 128 + m * 16;
#pragma unroll
        for (int bj = 0; bj < 2; ++bj) {
          f32x4 v0 = acc[ai][bj][m][0], v1 = acc[ai][bj][m][1];
          u32x4 o = {pk2(v0[0], v0[1]), pk2(v0[2], v0[3]), pk2(v1[0], v1[1]), pk2(v1[2], v1[3])};
          const int cl = cl0 + bj * 128;
          if (cx) {
            const int c = (u.pn - 12) * 256 + cl;
            *(u32x4*)(ub + (((unsigned)(c >> 4) * T + r) * 16u + (c & 15))) = o;
          } else {
            *(u32x4*)(z + (r * NZ + zc + cl)) = o;
          }
        }
      }
  }
};
DEVI void ph_gemm1(KP P, int layer, int bid, int nblk, LAS unsigned char* lds) {
  pg8::SchedStd S{(const char*)P->hn, (const char*)(P->wt_in + (size_t)layer * 9216 * 1024), 2048u, 2048u, 128, 20, bid, nblk};
  EpiZ1 E{P->z, P->ub};
  pg8::gemm_phase<true>(lds, S, E, 1024);
}

constexpr int PL_XS = 272;
constexpr int PL_POFF = 144 * PL_XS;
DEVI void ph_pool(KP P, int layer, int bid, int nblk, LAS unsigned char* lds) {
  const int tid = tidx(), lane = tid & 63, wave = tid >> 6, l15 = lane & 15, q4 = lane >> 4;
  const bool skew = (nblk == 256);
  const int nmine = skew ? (bid < 128 ? 2 : 6) : (1024 - bid + nblk - 1) / nblk;
  for (int k = 0; k < nmine; ++k) {
    const int it = skew ? (bid < 128 ? 768 + bid + 128 * k : (bid - 128) + 128 * k) : bid + k * nblk;
    const int tm = it >> 2, g = it & 3;
    const int win = 2 << g, half = win >> 1;
    const int t0 = tm * 128, s0 = t0 & 4095;
    const unsigned tbase = (unsigned)(t0 - s0);
    __syncthreads();
    for (int idx = tid; idx < 144 * 16; idx += NT) {
      const int r = idx >> 4, c = idx & 15, sq = s0 - 8 + r;
      u32x4_t v = {0u, 0u, 0u, 0u};
      if (sq >= 0 && sq < 4096) v = *(const u32x4_t*)(P->z + ((tbase + sq) * NZ + ZD_X + g * 128 + c * 8));
      *(LAS u32x4_t*)(lds + r * PL_XS + c * 16) = v;
    }
    __syncthreads();
    {
      const int c = tid & 15, strip = tid >> 4;
      float acc[8];
#pragma unroll
      for (int e = 0; e < 8; ++e) acc[e] = 0.f;
      const int j0 = strip * 4;
      const LAS unsigned char* xb = lds + c * 16;
      for (int w = 0; w < win; ++w) {
        const u32x4_t v = *(const LAS u32x4_t*)(xb + (j0 + 8 - half + w) * PL_XS);
#pragma unroll
        for (int e = 0; e < 4; ++e) { acc[2 * e] += lo16(v[e]); acc[2 * e + 1] += hi16(v[e]); }
      }
#pragma unroll
      for (int j = 0; j < 4; ++j) {
        const int sq = s0 + j0 + j;
        const int lo = max(sq - half, 0), hi = min(sq - half + win, 4096);
        const float ic = __builtin_amdgcn_rcpf((float)(hi - lo));
        const u32x4_t self = *(const LAS u32x4_t*)(xb + (j0 + j + 8) * PL_XS);
        float o[8];
#pragma unroll
        for (int e = 0; e < 4; ++e) { o[2 * e] = acc[2 * e] * ic - lo16(self[e]); o[2 * e + 1] = acc[2 * e + 1] * ic - hi16(self[e]); }
        *(LAS u32x4_t*)(lds + PL_POFF + (j0 + j) * PL_XS + c * 16) = (u32x4_t){pk2(o[0], o[1]), pk2(o[2], o[3]), pk2(o[4], o[5]), pk2(o[6], o[7])};
        if (j < 3) {
          const u32x4_t vin = *(const LAS u32x4_t*)(xb + (j0 + j + 8 - half + win) * PL_XS);
          const u32x4_t vout = *(const LAS u32x4_t*)(xb + (j0 + j + 8 - half) * PL_XS);
#pragma unroll
          for (int e = 0; e < 4; ++e) { acc[2 * e] += lo16(vin[e]) - lo16(vout[e]); acc[2 * e + 1] += hi16(vin[e]) - hi16(vout[e]); }
        }
      }
    }
    __syncthreads();
    {
      const int r0 = (wave >> 1) * 32, n0 = (wave & 1) * 64;
      const u16* bp = P->wt_pool + ((size_t)(layer * 4 + g) * 128 + n0 + l15) * 128 + q4 * 8;
      f32x4 acc[2][4];
#pragma unroll
      for (int i = 0; i < 2; ++i)
#pragma unroll
        for (int j = 0; j < 4; ++j) acc[i][j] = f32x4{0.f, 0.f, 0.f, 0.f};
#pragma unroll
      for (int k0 = 0; k0 < 128; k0 += 32) {
        bf16x8 a[2], bfr[4];
#pragma unroll
        for (int i = 0; i < 2; ++i) a[i] = *(const LAS bf16x8*)(lds + PL_POFF + (r0 + i * 16 + l15) * PL_XS + (k0 + q4 * 8) * 2);
#pragma unroll
        for (int j = 0; j < 4; ++j) bfr[j] = ld8(bp + (size_t)j * 16 * 128 + k0);
#pragma unroll
        for (int i = 0; i < 2; ++i)
#pragma unroll
          for (int j = 0; j < 4; ++j) acc[i][j] = mfma(a[i], bfr[j], acc[i][j]);
      }
#pragma unroll
      for (int i = 0; i < 2; ++i)
#pragma unroll
        for (int j = 0; j < 4; ++j) {
          const int ch = g * 128 + n0 + j * 16 + l15;
          const float sc = P->pool_scale[layer * 512 + ch];
#pragma unroll
          for (int e = 0; e < 4; ++e) {
            const unsigned t = t0 + r0 + i * 16 + q4 * 4 + e;
            u16* zp = P->z + (t * NZ + ZD_G + ch);
            *zp = f2bf(acc[i][j][e] * sc * silu(bf2f(*zp)));
          }
        }
    }
  }
  __syncthreads();
}

template <bool FINAL>
DEVI void lru_unit(KP P, int layer, int u, int lane) {
  asm volatile("" : "+v"(lane));
  int l15 = lane & 15, q4 = lane >> 4;
  const float* cw = P->conv_w + layer * 4 * 512;
  const float* cb = P->conv_b + layer * 512;
  int b = u >> 9, c = (u >> 3) & 63, n = u & 7;
  int s0 = c * 64;
  unsigned tb = (unsigned)b * 4096u;
  bf16x8 xa[4][2];
#pragma unroll
  for (int ks = 0; ks < 2; ++ks) {
    int ch0 = n * 64 + ks * 32 + q4 * 8;
    float wv[4][8], bb[8];
#pragma unroll
    for (int e = 0; e < 8; ++e) bb[e] = cb[ch0 + e];
#pragma unroll
    for (int j = 0; j < 4; ++j)
#pragma unroll
      for (int e = 0; e < 8; ++e) wv[j][e] = cw[j * 512 + ch0 + e];
#pragma unroll
    for (int mt = 0; mt < 4; ++mt) {
      int s = s0 + mt * 16 + l15;
      float v[8];
#pragma unroll
      for (int e = 0; e < 8; ++e) v[e] = bb[e];
#pragma unroll
      for (int j = 0; j < 4; ++j) {
        int sj = s + j - 2;
        if (sj >= 0 && sj < 4096) {
          bf16x8 r = ld8(P->z + (unsigned)((tb + sj) * NZ + ZA_X + ch0));
#pragma unroll
          for (int e = 0; e < 8; ++e) v[e] += bfs(r[e]) * wv[j][e];
        }
      }
      xa[mt][ks] = pack8(v);
    }
    __builtin_amdgcn_sched_barrier(0);
  }
#pragma unroll 1
  for (int nt = 0; nt < 4; ++nt) {
    int ch = n * 64 + nt * 16 + l15;
    f32x4 xcv[4];
    {
#pragma unroll
      for (int mt = 0; mt < 4; ++mt) xcv[mt] = f32x4{0.f, 0.f, 0.f, 0.f};
#pragma unroll
      for (int ks = 0; ks < 2; ++ks) {
        bf16x8 id;
#pragma unroll
        for (int e = 0; e < 8; ++e) id[e] = (ks * 32 + q4 * 8 + e == nt * 16 + l15) ? (short)0x3f80 : (short)0;
#pragma unroll
        for (int mt = 0; mt < 4; ++mt) xcv[mt] = mfma(xa[mt][ks], id, xcv[mt]);
      }
    }
    float hout[4][4];
    u16 gav[4][4];
#pragma unroll
    for (int mt = 0; mt < 4; ++mt)
#pragma unroll
      for (int j = 0; j < 4; ++j) {
        hout[mt][j] = 0.f;
        if (FINAL) gav[mt][j] = P->z[(unsigned)((tb + s0 + mt * 16 + q4 * 4 + j) * NZ + ZA_G + ch)];
      }
    f32x4 ar[2][4], ai[2][4];
    float brb[2], bib[2], sp[2], h_run[2], p_run[2];
    size_t ci[2];
#pragma unroll
    for (int dir = 0; dir < 2; ++dir) {
#pragma unroll
      for (int mt = 0; mt < 4; ++mt) { ar[dir][mt] = f32x4{0.f, 0.f, 0.f, 0.f}; ai[dir][mt] = f32x4{0.f, 0.f, 0.f, 0.f}; }
      size_t wo = ((size_t)((layer * 2 + dir) * 8 + n) * 64 + nt * 16 + l15) * 64 + q4 * 8;
#pragma unroll
      for (int ks = 0; ks < 2; ++ks) {
        bf16x8 br = ld8(P->wt_lr + wo + ks * 32), bi = ld8(P->wt_li + wo + ks * 32);
#pragma unroll
        for (int mt = 0; mt < 4; ++mt) {
          ar[dir][mt] = mfma(xa[mt][ks], br, ar[dir][mt]);
          ai[dir][mt] = mfma(xa[mt][ks], bi, ai[dir][mt]);
        }
      }
      int pi = (layer * 2 + dir) * 512 + ch;
      brb[dir] = P->b_r[pi] * -1.4426950408889634f;
      bib[dir] = P->b_i[pi] * -1.4426950408889634f;
      sp[dir] = __logf(1.f + __expf(-P->lam[pi])) * (-8.f * 1.4426950408889634f);
      ci[dir] = (((size_t)b * 64 + c) * 2 + dir) * 512 + ch;
      h_run[dir] = FINAL ? P->lcar[ci[dir]] : 0.f;
      p_run[dir] = 1.f;
    }
#pragma unroll
    for (int mi = 0; mi < 4; ++mi) {
#pragma unroll
      for (int dir = 0; dir < 2; ++dir) {
        const int mt = dir == 0 ? mi : 3 - mi;
        float av[4], bv[4];
#pragma unroll
        for (int j = 0; j < 4; ++j) {
          float r = __builtin_amdgcn_rcpf(1.f + __builtin_amdgcn_exp2f(__builtin_fmaf(ar[dir][mt][j], -1.4426950408889634f, brb[dir])));
          float gi = __builtin_amdgcn_rcpf(1.f + __builtin_amdgcn_exp2f(__builtin_fmaf(ai[dir][mt][j], -1.4426950408889634f, bib[dir])));
          av[j] = __builtin_amdgcn_exp2f(r * sp[dir]);
          bv[j] = __builtin_amdgcn_sqrtf(__builtin_fmaf(-av[j], av[j], 1.f)) * (gi * xcv[mt][j]);
        }
        float Pl = av[0] * av[1] * av[2] * av[3], Hl;
        if (dir == 0) Hl = ((bv[0] * av[1] + bv[1]) * av[2] + bv[2]) * av[3] + bv[3];
        else Hl = ((bv[3] * av[2] + bv[2]) * av[1] + bv[1]) * av[0] + bv[0];
        float hq = h_run[dir];
#pragma unroll
        for (int qi = 0; qi < 3; ++qi) {
          int qq = dir == 0 ? qi : 3 - qi;
          float Pq = __shfl(Pl, l15 + 16 * qq), Hq = __shfl(Hl, l15 + 16 * qq);
          bool use = dir == 0 ? (qq < q4) : (qq > q4);
          if (use) hq = Pq * hq + Hq;
        }
        if (FINAL) {
          float h = hq;
#pragma unroll
          for (int ji = 0; ji < 4; ++ji) {
            int j = dir == 0 ? ji : 3 - ji;
            h = av[j] * h + bv[j];
            hout[mt][j] += h;
          }
        }
        float full = Pl * hq + Hl;
        h_run[dir] = __shfl(full, l15 + (dir == 0 ? 48 : 0));
        if (!FINAL) {
          float pt = Pl * __shfl_xor(Pl, 16);
          pt *= __shfl_xor(pt, 32);
          p_run[dir] *= pt;
        }
      }
    }
    if (!FINAL && q4 == 0) {
#pragma unroll
      for (int dir = 0; dir < 2; ++dir) {
        P->lagg[ci[dir] * 2] = p_run[dir];
        P->lagg[ci[dir] * 2 + 1] = h_run[dir];
      }
    }
    if (FINAL) {
#pragma unroll
      for (int mt = 0; mt < 4; ++mt)
#pragma unroll
        for (int j = 0; j < 4; ++j) {
          u16* zp = P->z + (unsigned)((tb + s0 + mt * 16 + q4 * 4 + j) * NZ + ZA_G + ch);
          *zp = f2bf(hout[mt][j] * silu(bf2f(gav[mt][j])));
        }
    }
  }
}

DEVI void ph_lru_carry(KP P, int bid, int nblk) {
  for (int idx = bid * NT + tidx(); idx < 8 * 2 * 512; idx += nblk * NT) {
    int ch = idx & 511, dir = (idx >> 9) & 1, b = idx >> 10;
    float h = 0.f;
    for (int c0 = 0; c0 < 64; c0 += 16) {
      float2 ag[16];
#pragma unroll
      for (int k = 0; k < 16; ++k) {
        const int c = dir == 0 ? c0 + k : 63 - (c0 + k);
        const size_t o = (((size_t)b * 64 + c) * 2 + dir) * 512 + ch;
        ag[k] = *(const float2*)(P->lagg + o * 2);
      }
#pragma unroll
      for (int k = 0; k < 16; ++k) {
        const int c = dir == 0 ? c0 + k : 63 - (c0 + k);
        const size_t o = (((size_t)b * 64 + c) * 2 + dir) * 512 + ch;
        P->lcar[o] = h;
        h = ag[k].x * h + ag[k].y;
      }
    }
  }
}

typedef __attribute__((ext_vector_type(2))) __bf16 bf2_t;
DEVI float dot2sq(unsigned x, float c) {
  bf2_t v = __builtin_bit_cast(bf2_t, x);
  return __builtin_amdgcn_fdot2_f32_bf16(v, v, c, false);
}
constexpr int NA_RS = 144;
constexpr int NA_VOFF = 16384;
DEVI void na_unit(KP P, int layer, int u, int lane, const LAS float* rpl, LAS unsigned char* vb) {
  asm volatile("" : "+v"(lane));
  const int l15 = lane & 15, q4 = lane >> 4;
  const int h = u & 7, jb = (u >> 3) & 3, r = (u >> 5) & 63, b = u >> 11;
  const int rs = min(max(r - 4, 0), 56);
  const int bs = min(max(16 * jb - 8, 0), 32);
  const unsigned tb = (unsigned)b * 4096u;
  const float LOG2E = 1.4426950408889634f;
  bf16x8 qf[2];
  {
    const unsigned tq = tb + r * 64 + jb * 16 + l15;
    u32x4_t raw[2];
    float ss = 0.f;
#pragma unroll
    for (int ks = 0; ks < 2; ++ks) {
      raw[ks] = *(const u32x4_t*)(P->z + (tq * NZ + ZQ + h * 64 + ks * 32 + q4 * 8));
#pragma unroll
      for (int e = 0; e < 4; ++e) ss = dot2sq(raw[ks][e], ss);
    }
    ss += __shfl_xor(ss, 16);
    ss += __shfl_xor(ss, 32);
    const float rq = rsqrtf(ss * (1.f / 64.f) + 1e-6f) * (0.125f * LOG2E);
#pragma unroll
    for (int ks = 0; ks < 2; ++ks) {
      const float* qg = P->q_gain + layer * 64 + ks * 32 + q4 * 8;
      const float* kg = P->k_gain + layer * 64 + ks * 32 + q4 * 8;
      float v[8];
#pragma unroll
      for (int e = 0; e < 4; ++e) {
        v[2 * e] = lo16(raw[ks][e]) * rq * qg[2 * e] * kg[2 * e];
        v[2 * e + 1] = hi16(raw[ks][e]) * rq * qg[2 * e + 1] * kg[2 * e + 1];
      }
      qf[ks] = pack8(v);
    }
  }
  u16 gv[4][4];
#pragma unroll
  for (int j = 0; j < 4; ++j)
#pragma unroll
    for (int dt = 0; dt < 4; ++dt) gv[j][dt] = P->z[(tb + r * 64 + jb * 16 + q4 * 4 + j) * NZ + ZB_G + h * 64 + dt * 16 + l15];
  const int qcol = jb * 16 + l15;
  const int ws = min(max(qcol - 8, 0), 48);
  unsigned vmask = 0;
  int dcx[2][4];
#pragma unroll
  for (int t = 0; t < 2; ++t)
#pragma unroll
    for (int j = 0; j < 4; ++j) {
      const int kcol = bs + 8 * q4 + 4 * t + j;
      if (kcol >= ws && kcol < ws + 16) vmask |= 1u << (t * 4 + j);
      dcx[t][j] = min(max(kcol - qcol, -15), 15) + 15;
    }
  const LAS float* rp = rpl + h * 465 + (rs - r + 7) * 31;
  const int kxa = 8 * (l15 >> 2) + (l15 & 3);
  const unsigned kbase = (tb + rs * 64 + bs + kxa) * NZ + ZK + h * 64 + q4 * 8;
  f32x4 sc[16];
  u32x4_t kq[16][2];
#pragma unroll
  for (int i = 0; i < 16; ++i) {
    const unsigned ko = kbase + (unsigned)((i >> 1) * 64 + 4 * (i & 1)) * NZ;
    kq[i][0] = *(const u32x4_t*)(P->z + ko);
    kq[i][1] = *(const u32x4_t*)(P->z + ko + 32);
  }
#pragma unroll
  for (int gi = 0; gi < 2; ++gi) {
    float rkv[8];
#pragma unroll
    for (int i = 0; i < 8; ++i) {
      const int nt = gi * 8 + i;
      float ss = 0.f;
#pragma unroll
      for (int e = 0; e < 4; ++e) { ss = dot2sq(kq[nt][0][e], ss); ss = dot2sq(kq[nt][1][e], ss); }
      ss += __shfl_xor(ss, 16);
      ss += __shfl_xor(ss, 32);
      rkv[i] = rsqrtf(ss * (1.f / 64.f) + 1e-6f);
      f32x4 a = f32x4{0.f, 0.f, 0.f, 0.f};
      a = mfma(__builtin_bit_cast(bf16x8, kq[nt][0]), qf[0], a);
      a = mfma(__builtin_bit_cast(bf16x8, kq[nt][1]), qf[1], a);
      sc[nt] = a;
    }
#pragma unroll
    for (int i = 0; i < 8; ++i) {
      const int nt = gi * 8 + i, kri = nt >> 1, t = nt & 1;
#pragma unroll
      for (int j = 0; j < 4; ++j) {
        const float rkj = __shfl(rkv[i], (lane & 48) + 4 * q4 + j);
        const float bias = rp[kri * 31 + dcx[t][j]];
        sc[nt][j] = ((vmask >> (t * 4 + j)) & 1u) ? sc[nt][j] * rkj + bias : -1e30f;
      }
    }
    __builtin_amdgcn_sched_barrier(0);
  }
  const unsigned vg0 = (tb + rs * 64 + bs + (lane >> 3)) * NZ + ZV + h * 64 + (lane & 7) * 8;
  u32x4_t vreg[8][4];
#pragma unroll
  for (int s8 = 0; s8 < 4; ++s8)
#pragma unroll
    for (int i = 0; i < 4; ++i) vreg[s8][i] = *(const u32x4_t*)(P->z + vg0 + (unsigned)(s8 * 64 + 8 * i) * NZ);
  float mx = -1e30f;
#pragma unroll
  for (int nt = 0; nt < 16; ++nt)
#pragma unroll
    for (int j = 0; j < 4; ++j) mx = fmaxf(mx, sc[nt][j]);
  mx = fmaxf(mx, __shfl_xor(mx, 16));
  mx = fmaxf(mx, __shfl_xor(mx, 32));
  float sum = 0.f;
#pragma unroll
  for (int nt = 0; nt < 16; ++nt)
#pragma unroll
    for (int j = 0; j < 4; ++j) {
      const float pv = __builtin_amdgcn_exp2f(sc[nt][j] - mx);
      sc[nt][j] = pv;
      sum += pv;
    }
  sum += __shfl_xor(sum, 16);
  sum += __shfl_xor(sum, 32);
  u32x4_t pfu[8];
#pragma unroll
  for (int s8 = 0; s8 < 8; ++s8)
    pfu[s8] = (u32x4_t){pk2(sc[2 * s8][0], sc[2 * s8][1]), pk2(sc[2 * s8][2], sc[2 * s8][3]), pk2(sc[2 * s8 + 1][0], sc[2 * s8 + 1][1]),
                        pk2(sc[2 * s8 + 1][2], sc[2 * s8 + 1][3])};
  __builtin_amdgcn_sched_barrier(0);
#pragma unroll
  for (int s8 = 4; s8 < 8; ++s8)
#pragma unroll
    for (int i = 0; i < 4; ++i) vreg[s8][i] = *(const u32x4_t*)(P->z + vg0 + (unsigned)(s8 * 64 + 8 * i) * NZ);
  f32x4 oacc[4];
#pragma unroll
  for (int dt = 0; dt < 4; ++dt) oacc[dt] = f32x4{0.f, 0.f, 0.f, 0.f};
  LAS unsigned char* vw = vb + (lane >> 3) * NA_RS + (lane & 7) * 16;
  const unsigned vr = (unsigned)(size_t)(vb + (8 * q4 + (l15 >> 2)) * NA_RS + 8 * (lane & 3));
#pragma unroll
  for (int s8 = 0; s8 < 8; ++s8) {
#pragma unroll
    for (int i = 0; i < 4; ++i) *(LAS u32x4_t*)(vw + 8 * i * NA_RS) = vreg[s8][i];
    typedef unsigned u32x2_t __attribute__((ext_vector_type(2)));
    u32x2_t t0, t1, t2, t3, t4, t5, t6, t7;
    asm volatile(
        "s_waitcnt lgkmcnt(0)\n\t"
        "ds_read_b64_tr_b16 %0, %8\n\t"
        "ds_read_b64_tr_b16 %1, %8 offset:576\n\t"
        "ds_read_b64_tr_b16 %2, %8 offset:32\n\t"
        "ds_read_b64_tr_b16 %3, %8 offset:608\n\t"
        "ds_read_b64_tr_b16 %4, %8 offset:64\n\t"
        "ds_read_b64_tr_b16 %5, %8 offset:640\n\t"
        "ds_read_b64_tr_b16 %6, %8 offset:96\n\t"
        "ds_read_b64_tr_b16 %7, %8 offset:672\n\t"
        "s_waitcnt lgkmcnt(0)"
        : "=&v"(t0), "=&v"(t1), "=&v"(t2), "=&v"(t3), "=&v"(t4), "=&v"(t5), "=&v"(t6), "=&v"(t7)
        : "v"(vr)
        : "memory");
    const bf16x8 pf = __builtin_bit_cast(bf16x8, pfu[s8]);
    oacc[0] = mfma(pf, __builtin_bit_cast(bf16x8, (u32x4_t){t0[0], t0[1], t1[0], t1[1]}), oacc[0]);
    oacc[1] = mfma(pf, __builtin_bit_cast(bf16x8, (u32x4_t){t2[0], t2[1], t3[0], t3[1]}), oacc[1]);
    oacc[2] = mfma(pf, __builtin_bit_cast(bf16x8, (u32x4_t){t4[0], t4[1], t5[0], t5[1]}), oacc[2]);
    oacc[3] = mfma(pf, __builtin_bit_cast(bf16x8, (u32x4_t){t6[0], t6[1], t7[0], t7[1]}), oacc[3]);
  }
#pragma unroll
  for (int j = 0; j < 4; ++j) {
    const float inv = __builtin_amdgcn_rcpf(__shfl(sum, q4 * 4 + j));
    const unsigned t = tb + r * 64 + jb * 16 + q4 * 4 + j;
#pragma unroll
    for (int dt = 0; dt < 4; ++dt) {
      u16* zp = P->z + (t * NZ + ZB_G + h * 64 + dt * 16 + l15);
      *zp = f2bf(oacc[dt][j] * inv * silu(bf2f(gv[j][dt])));
    }
  }
}

struct SchedS5U {
  const char* ub; const char* B; unsigned ldb2; size_t bgs;
  int nPN, nUnits, c, G;
  DEVI bool next(int i, pg8::Unit& u) const {
    const int L = i * G + c;
    if (L >= nUnits) return false;
    u.pn = L % nPN; u.pm = (L / nPN) & 3; u.g = L / (nPN * 4);
    return true;
  }
  DEVI const char* a_base(const pg8::Unit& u) const { return ub + ((size_t)u.g * 1024 + (size_t)u.pm * 256) * 1024; }
  DEVI const char* b_base(const pg8::Unit& u) const { return B + (size_t)u.g * bgs + (size_t)u.pn * 256 * ldb2; }
  DEVI unsigned a_voff(int R, int C) const { return (unsigned)R * 1024u + C * 2; }
  DEVI unsigned b_voff(int R, int C) const { return (unsigned)R * ldb2 + C * 2; }
  DEVI size_t a_kstep() const { return 128; }
  DEVI size_t b_kstep() const { return 128; }
  DEVI size_t a_hstep() const { return (size_t)128 * 1024; }
  DEVI size_t b_hstep() const { return (size_t)128 * ldb2; }
};
struct EpiE {
  static constexpr bool CHAIN = false;
  u16* O;
  DEVI void operator()(const Acc8& acc, const pg8::Unit& u, int wr, int wc, int fr, int fq) const {
    const int row0 = u.g * 1024 + u.pm * 256 + wr * 64 + fr, col0 = wc * 32 + 8 * fq;
#pragma unroll
    for (int ai = 0; ai < 2; ++ai)
#pragma unroll
      for (int m = 0; m < 4; ++m) {
        u16* rowp = O + (size_t)(row0 + ai * 128 + m * 16) * 256 + col0;
#pragma unroll
        for (int bj = 0; bj < 2; ++bj) {
          f32x4 v0 = acc[ai][bj][m][0], v1 = acc[ai][bj][m][1];
          u32x4 o = {pk2(v0[0], v0[1]), pk2(v0[2], v0[3]), pk2(v1[0], v1[1]), pk2(v1[2], v1[3])};
          *(u32x4*)(rowp + bj * 128) = o;
        }
      }
  }
};
DEVI void s5_g1(KP P, int bid, int nblk, LAS unsigned char* lds) {
  SchedS5U S{(const char*)P->ub, (const char*)P->w1, 1024u, (size_t)256 * 512 * 2, 1, 128, bid, nblk};
  EpiE E{P->ecar};
  pg8::gemm_phase<true>(lds, S, E, 512);
}

DEVI void ph_s5_carry(KP P, int layer, int bid, int nblk) {
  for (int idx = bid * NT + tidx(); idx < 8 * 32 * 2 * 64; idx += nblk * NT) {
    int p = idx & 63, d = (idx >> 6) & 1, g = (idx >> 7) & 31, b = idx >> 12;
    CP c = s5p(P, layer, d, g, p);
    float ar, ai;
    cpow(c, 32.f, ar, ai);
    float hr = 0.f, hi = 0.f;
    u16* base = P->ecar + ((size_t)g * 1024 + b * 128) * 256 + d * 128 + p;
    for (int c0 = 0; c0 < 128; c0 += 16) {
      u16 er[16], ei[16];
#pragma unroll
      for (int k = 0; k < 16; ++k) {
        const int cc = d == 0 ? c0 + k : 127 - (c0 + k);
        er[k] = base[(size_t)cc * 256];
        ei[k] = base[(size_t)cc * 256 + 64];
      }
#pragma unroll
      for (int k = 0; k < 16; ++k) {
        const int cc = d == 0 ? c0 + k : 127 - (c0 + k);
        base[(size_t)cc * 256] = f2bf(hr);
        base[(size_t)cc * 256 + 64] = f2bf(hi);
        const float nr = ar * hr - ai * hi + bf2f(er[k]), ni = ar * hi + ai * hr + bf2f(ei[k]);
        hr = nr;
        hi = ni;
      }
    }
  }
}

struct SchedS5C {
  const char* A; const char* B; int c, G;
  DEVI bool next(int i, pg8::Unit& u) const {
    const int L = i * G + c;
    if (L >= 256) return false;
    u.pn = L & 1; u.pm = (L >> 1) & 3; u.g = L >> 3;
    return true;
  }
  DEVI const char* a_base(const pg8::Unit& u) const { return A + ((size_t)u.g * 1024 + u.pm * 256) * 512; }
  DEVI const char* b_base(const pg8::Unit& u) const { return B + ((size_t)u.g * 512 + u.pn * 256) * 1536 + 1024; }
  DEVI unsigned a_voff(int R, int C) const { return (unsigned)R * 512u + C * 2; }
  DEVI unsigned b_voff(int R, int C) const { return (unsigned)R * 1536u + C * 2; }
  DEVI size_t a_kstep() const { return 128; }
  DEVI size_t b_kstep() const { return 128; }
  DEVI size_t a_hstep() const { return (size_t)128 * 512; }
  DEVI size_t b_hstep() const { return (size_t)128 * 1536; }
};
template <bool SECOND>
struct EpiYg {
  static constexpr bool CHAIN = false;
  u16* z; const u16* ub; const float* dsk;
  DEVI void operator()(const Acc8& acc, const pg8::Unit& u, int wr, int wc, int fr, int fq) const {
    const int m0 = u.pm * 256 + wr * 64 + fr, n00 = u.pn * 256 + wc * 32 + 8 * fq;
#pragma unroll
    for (int ai = 0; ai < 2; ++ai)
#pragma unroll
      for (int bj = 0; bj < 2; ++bj) {
        const int n0 = n00 + bj * 128;
        const int ch = u.g * 16 + (n0 & 15);
        f32x4 d0, d1;
        if (SECOND) { d0 = *(const f32x4*)(dsk + ch); d1 = *(const f32x4*)(dsk + ch + 4); }
#pragma unroll
        for (int mh = 0; mh < 2; ++mh) {
          u32x4 pp[2], uu[2];
          u16* yp[2];
#pragma unroll
          for (int mm = 0; mm < 2; ++mm) {
            const int m = mh * 2 + mm;
            const unsigned t = (unsigned)(m0 + ai * 128 + m * 16) * 32u + (n0 >> 4);
            yp[mm] = z + (t * NZ + ZYG + ch);
            if (SECOND) {
              pp[mm] = *(const u32x4*)yp[mm];
              uu[mm] = *(const u32x4*)(ub + (((unsigned)u.g * T + t) * 16u + (n0 & 15)));
            }
          }
#pragma unroll
          for (int mm = 0; mm < 2; ++mm) {
            const int m = mh * 2 + mm;
            f32x4 v0 = acc[ai][bj][m][0], v1 = acc[ai][bj][m][1];
            float v[8] = {v0[0], v0[1], v0[2], v0[3], v1[0], v1[1], v1[2], v1[3]};
            if (SECOND) {
              float dd[8] = {d0[0], d0[1], d0[2], d0[3], d1[0], d1[1], d1[2], d1[3]};
#pragma unroll
              for (int e = 0; e < 4; ++e) {
                v[2 * e] = gelu_t(v[2 * e] + lo16(pp[mm][e]) + dd[2 * e] * lo16(uu[mm][e]));
                v[2 * e + 1] = gelu_t(v[2 * e + 1] + hi16(pp[mm][e]) + dd[2 * e + 1] * hi16(uu[mm][e]));
              }
            }
            u32x4 o = {pk2(v[0], v[1]), pk2(v[2], v[3]), pk2(v[4], v[5]), pk2(v[6], v[7])};
            *(u32x4*)yp[mm] = o;
          }
          __builtin_amdgcn_sched_barrier(0);
        }
      }
  }
};
DEVI void s5_g2(KP P, int layer, int bid, int nblk, LAS unsigned char* lds) {
  {
    SchedS5C S{(const char*)P->ecar, (const char*)P->bg2, bid, nblk};
    EpiYg<false> E{P->z, P->ub, P->s_d + layer * 512};
    pg8::gemm_phase<true>(lds, S, E, 256);
  }
  {
    SchedS5U S{(const char*)P->ub, (const char*)P->bg2, 1536u, (size_t)512 * 768 * 2, 2, 256, bid, nblk};
    EpiYg<true> E{P->z, P->ub, P->s_d + layer * 512};
    pg8::gemm_phase<true>(lds, S, E, 512);
  }
}

struct EpiGlu {
  static constexpr bool CHAIN = false;
  u16* z; const float* gb;
  DEVI void operator()(const Acc8& acc, const pg8::Unit& u, int wr, int wc, int fr, int fq) const {
    const int row0 = u.pm * 256 + wr * 64 + fr, col0 = u.pn * 256 + wc * 32 + 8 * fq;
#pragma unroll
    for (int ai = 0; ai < 2; ++ai)
#pragma unroll
      for (int bj = 0; bj < 2; ++bj) {
        const int c = col0 + bj * 128;
        u32x4 yg[4], cg[4];
#pragma unroll
        for (int m = 0; m < 4; ++m) {
          u16* rowp = z + (unsigned)(row0 + ai * 128 + m * 16) * NZ;
          yg[m] = *(const u32x4*)(rowp + ZYG + c);
          cg[m] = *(const u32x4*)(rowp + ZC_G + c);
        }
        const f32x4 b0 = *(const f32x4*)(gb + c), b1 = *(const f32x4*)(gb + c + 4);
#pragma unroll
        for (int m = 0; m < 4; ++m) {
          u16* rowp = z + (unsigned)(row0 + ai * 128 + m * 16) * NZ;
          f32x4 v0 = acc[ai][bj][m][0] + b0, v1 = acc[ai][bj][m][1] + b1;
          float v[8] = {v0[0], v0[1], v0[2], v0[3], v1[0], v1[1], v1[2], v1[3]};
#pragma unroll
          for (int e = 0; e < 4; ++e) {
            v[2 * e] = lo16(yg[m][e]) * sigm(v[2 * e]) * silu(lo16(cg[m][e]));
            v[2 * e + 1] = hi16(yg[m][e]) * sigm(v[2 * e + 1]) * silu(hi16(cg[m][e]));
          }
          u32x4 o = {pk2(v[0], v[1]), pk2(v[2], v[3]), pk2(v[4], v[5]), pk2(v[6], v[7])};
          *(u32x4*)(rowp + ZC_G + c) = o;
        }
        __builtin_amdgcn_sched_barrier(0);
      }
  }
};
DEVI void ph_glu(KP P, int layer, int bid, int nblk, LAS unsigned char* lds) {
  pg8::SchedStd S{(const char*)(P->z + ZYG), (const char*)(P->wt_glu + (size_t)layer * 512 * 512), (unsigned)NZ * 2, 1024u, 128, 2, bid, nblk};
  EpiGlu E{P->z, P->glu_b + layer * 512};
  pg8::gemm_phase<true>(lds, S, E, 512);
}

struct SchedNB {
  const char* A; const char* B; unsigned lda2, ldb2; size_t b_nb; bool a_cols; int c, G;
  DEVI bool next(int i, pg8::Unit& u) const {
    if (i >= 8) return false;
    const int L = (i >> 2) * G + c;
    if (L >= 512) return false;
    pg8::tile_of(L, 128, 4, u.pm, u.pn); u.g = i & 3;
    return true;
  }
  DEVI const char* a_base(const pg8::Unit& u) const {
    const int gc = u.g == 0 ? ZA_G : u.g == 1 ? ZB_G : u.g == 2 ? ZC_G : ZD_G;
    return A + (a_cols ? gc * 2 : 0) + (size_t)u.pm * 256 * lda2;
  }
  DEVI const char* b_base(const pg8::Unit& u) const { return B + (size_t)u.g * b_nb + (size_t)u.pn * 256 * ldb2; }
  DEVI unsigned a_voff(int R, int C) const { return (unsigned)R * lda2 + C * 2; }
  DEVI unsigned b_voff(int R, int C) const { return (unsigned)R * ldb2 + C * 2; }
  DEVI size_t a_kstep() const { return 128; }
  DEVI size_t b_kstep() const { return 128; }
  DEVI size_t a_hstep() const { return (size_t)128 * lda2; }
  DEVI size_t b_hstep() const { return (size_t)128 * ldb2; }
};
DEVI u16* gate_row(u16* z, u16* ub, int nb, unsigned r) {
  return nb == 3 ? ub + r * 512u : z + (r * NZ + (nb == 0 ? 0 : nb == 1 ? 2048 : ZD_X));
}
struct EpiGateU8 {
  static constexpr bool CHAIN = false;
  u16* z; u16* ub;
  DEVI void operator()(const Acc8& acc, const pg8::Unit& u, int wr, int wc, int fr, int fq) const {
    const int row0 = u.pm * 256 + wr * 64 + fr, cl0 = wc * 32 + 8 * fq;
#pragma unroll
    for (int ai = 0; ai < 2; ++ai)
#pragma unroll
      for (int m = 0; m < 4; ++m) {
        const unsigned r = row0 + ai * 128 + m * 16;
        u16* gp = gate_row(z, ub, u.g, r) + u.pn * 128;
#pragma unroll
        for (int bj = 0; bj < 2; ++bj) {
          const int cl = cl0 + bj * 128;
          f32x4 v0 = acc[ai][bj][m][0], v1 = acc[ai][bj][m][1];
          uint2 o = {0u, 0u};
#pragma unroll
          for (int e = 0; e < 4; ++e) {
            o.x = __builtin_amdgcn_cvt_pk_u8_f32(fmaxf(sigm(v0[e]) * 255.f, 1.f), e, o.x);
            o.y = __builtin_amdgcn_cvt_pk_u8_f32(fmaxf(sigm(v1[e]) * 255.f, 1.f), e, o.y);
          }
          *(uint2*)(gp + (cl >> 1)) = o;
        }
      }
  }
};
struct EpiMergeChain {
  static constexpr bool CHAIN = true;
  u16* z; u16* ub;
  DEVI bool keep(const pg8::Unit& u) const { return u.g < 3; }
  DEVI void operator()(Acc8& acc, const pg8::Unit& u, int wr, int wc, int fr, int fq) const {
    const int row0 = u.pm * 256 + wr * 64 + fr, cl0 = wc * 32 + 8 * fq;
    const int nb = u.g, nbn = nb < 3 ? nb + 1 : 3;
#pragma unroll
    for (int ai = 0; ai < 2; ++ai)
#pragma unroll
      for (int bj = 0; bj < 2; ++bj) {
        const int cl = cl0 + bj * 128;
        uint2 ga[4], gb[4];
#pragma unroll
        for (int m = 0; m < 4; ++m) {
          const unsigned r = row0 + ai * 128 + m * 16;
          ga[m] = *(const uint2*)(gate_row(z, ub, nb, r) + u.pn * 128 + (cl >> 1));
          gb[m] = *(const uint2*)(gate_row(z, ub, nbn, r) + u.pn * 128 + (cl >> 1));
        }
#pragma unroll
        for (int m = 0; m < 4; ++m) {
          const unsigned r = row0 + ai * 128 + m * 16;
          float f[8];
#pragma unroll
          for (int e = 0; e < 4; ++e) {
            const float a0 = (float)((ga[m].x >> (8 * e)) & 255u), a1 = (float)((ga[m].y >> (8 * e)) & 255u);
            const float b0 = (float)((gb[m].x >> (8 * e)) & 255u), b1 = (float)((gb[m].y >> (8 * e)) & 255u);
            f[e] = nb < 3 ? a0 * __builtin_amdgcn_rcpf(b0) : a0 * (1.f / 255.f);
            f[4 + e] = nb < 3 ? a1 * __builtin_amdgcn_rcpf(b1) : a1 * (1.f / 255.f);
          }
          f32x4 v0 = acc[ai][bj][m][0], v1 = acc[ai][bj][m][1];
#pragma unroll
          for (int e = 0; e < 4; ++e) { v0[e] *= f[e]; v1[e] *= f[4 + e]; }
          acc[ai][bj][m][0] = v0;
          acc[ai][bj][m][1] = v1;
          if (nb == 3) {
            u32x4 o = {pk2(v0[0], v0[1]), pk2(v0[2], v0[3]), pk2(v1[0], v1[1]), pk2(v1[2], v1[3])};
            *(u32x4*)(z + (r * NZ + ZMRG + u.pn * 256 + cl)) = o;
          }
        }
        __builtin_amdgcn_sched_barrier(0);
      }
  }
};
DEVI void ph_merge(KP P, int layer, int bid, int nblk, LAS unsigned char* lds) {
  {
    SchedNB S{(const char*)P->hn, (const char*)(P->wt_in + ((size_t)layer * 9216 + 5120) * 1024), 2048u, 2048u, (size_t)1024 * 1024 * 2, false, bid, nblk};
    EpiGateU8 E{P->z, P->ub};
    pg8::gemm_phase<true>(lds, S, E, 1024);
  }
  {
    SchedNB S{(const char*)P->z, (const char*)(P->wt_br + (size_t)layer * 4 * 1024 * 512), (unsigned)NZ * 2, 1024u, (size_t)1024 * 512 * 2, true, bid, nblk};
    EpiMergeChain E{P->z, P->ub};
    pg8::gemm_phase<true>(lds, S, E, 512);
  }
}

struct EpiWout {
  static constexpr bool CHAIN = false;
  const float* xin; float* out; u16* hn;
  DEVI void operator()(const Acc8& acc, const pg8::Unit& u, int wr, int wc, int fr, int fq) const {
    const int row0 = u.pm * 256 + wr * 64 + fr, col0 = u.pn * 256 + wc * 32 + 4 * fq;
#pragma unroll
    for (int ai = 0; ai < 2; ++ai)
#pragma unroll
      for (int m = 0; m < 4; ++m) {
        const unsigned ro = (unsigned)(row0 + ai * 128 + m * 16) * 1024u;
        f32x4 xv[2][2];
#pragma unroll
        for (int bj = 0; bj < 2; ++bj)
#pragma unroll
          for (int n = 0; n < 2; ++n) xv[bj][n] = *(const f32x4*)(xin + (ro + col0 + bj * 128 + n * 16));
#pragma unroll
        for (int bj = 0; bj < 2; ++bj)
#pragma unroll
          for (int n = 0; n < 2; ++n) {
            const unsigned o = ro + col0 + bj * 128 + n * 16;
            f32x4 v = xv[bj][n] + acc[ai][bj][m][n];
            *(f32x4*)(out + o) = v;
            uint2 h = {pk2(v[0], v[1]), pk2(v[2], v[3])};
            *(uint2*)(hn + o) = h;
          }
        if (m & 1) __builtin_amdgcn_sched_barrier(0);
      }
  }
};
DEVI void ph_wout(KP P, int layer, int bid, int nblk, LAS unsigned char* lds) {
  pg8::SchedStd S{(const char*)(P->z + ZMRG), (const char*)(P->wt_out + (size_t)layer * 1024 * 1024), (unsigned)NZ * 2, 2048u, 128, 4, bid, nblk};
  EpiWout E{layer == 0 ? P->x : P->out, P->out, P->hn};
  pg8::gemm_phase<false>(lds, S, E, 1024);
  const float* pl = P->p + (size_t)layer * T * 256;
  for (int idx = bid * NT + tidx(); idx < T * 32; idx += nblk * NT) {
    int t = idx >> 5, c = (idx & 31) * 8;
    f32x4 a = *(const f32x4*)(pl + (size_t)t * 256 + c), b = *(const f32x4*)(pl + (size_t)t * 256 + c + 4);
    u32x4 o = {pk2(a[0], a[1]), pk2(a[2], a[3]), pk2(b[0], b[1]), pk2(b[2], b[3])};
    *(u32x4*)(P->z + (size_t)t * NZ + c) = o;
  }
}

struct EpiPle {
  static constexpr bool CHAIN = false;
  const u16* z; float* out;
  DEVI void operator()(const Acc8& acc, const pg8::Unit& u, int wr, int wc, int fr, int fq) const {
    const int row0 = u.pm * 256 + wr * 64 + fr, col0 = u.pn * 256 + wc * 32 + 8 * fq;
#pragma unroll
    for (int ai = 0; ai < 2; ++ai)
#pragma unroll
      for (int bj = 0; bj < 2; ++bj) {
        const int c = col0 + bj * 128;
        u32x4 pr[4];
        f32x4 x0[4], x1[4];
#pragma unroll
        for (int m = 0; m < 4; ++m) {
          const unsigned r = row0 + ai * 128 + m * 16;
          pr[m] = *(const u32x4*)(z + (r * NZ + ZMRG + c));
          x0[m] = *(const f32x4*)(out + (r * 1024u + c));
          x1[m] = *(const f32x4*)(out + (r * 1024u + c + 4));
        }
#pragma unroll
        for (int m = 0; m < 4; ++m) {
          const unsigned r = row0 + ai * 128 + m * 16;
          f32x4 v0 = acc[ai][bj][m][0], v1 = acc[ai][bj][m][1];
          f32x4 a = x0[m], bq = x1[m];
          a[0] += sigm(v0[0]) * lo16(pr[m][0]); a[1] += sigm(v0[1]) * hi16(pr[m][0]);
          a[2] += sigm(v0[2]) * lo16(pr[m][1]); a[3] += sigm(v0[3]) * hi16(pr[m][1]);
          bq[0] += sigm(v1[0]) * lo16(pr[m][2]); bq[1] += sigm(v1[1]) * hi16(pr[m][2]);
          bq[2] += sigm(v1[2]) * lo16(pr[m][3]); bq[3] += sigm(v1[3]) * hi16(pr[m][3]);
          *(f32x4*)(out + (r * 1024u + c)) = a;
          *(f32x4*)(out + (r * 1024u + c + 4)) = bq;
        }
        __builtin_amdgcn_sched_barrier(0);
      }
  }
};
DEVI void ph_ple(KP P, int layer, int bid, int nblk, LAS unsigned char* lds) {
  {
    pg8::SchedStd S{(const char*)P->z, (const char*)(P->wt_pp + (size_t)layer * 1024 * 256), (unsigned)NZ * 2, 512u, 128, 4, bid, nblk};
    EpiZ E{P->z + ZMRG, (unsigned)NZ};
    pg8::gemm_phase<true>(lds, S, E, 256);
  }
  {
    pg8::SchedStd S{(const char*)P->hn, (const char*)(P->wt_pg + (size_t)layer * 1024 * 1024), 2048u, 2048u, 128, 4, bid, nblk};
    EpiPle E{P->z, P->out};
    pg8::gemm_phase<true>(lds, S, E, 1024);
  }
}

DEVI void ph_mix1(KP P, int layer, int bid, int nblk, LAS unsigned char* lds) {
  s5_g1(P, bid, nblk, lds);
  ph_pool(P, layer, bid, nblk, lds);
  {
    LAS float* rpl = (LAS float*)lds;
    __syncthreads();
    for (int i = tidx(); i < 8 * 465; i += NT) rpl[i] = P->rpb[layer * 8 * 465 + i] * 1.4426950408889634f;
    __syncthreads();
    int t = tidx(), lane = t & 63, wave = t >> 6;
    LAS unsigned char* vb = lds + NA_VOFF + wave * (32 * NA_RS);
    if (wave < 4) {
      for (int u = bid * 8 + wave; u < 4096; u += nblk * 8) lru_unit<false>(P, layer, u, lane);
      for (int u = bid * 8 + wave; u < 16384; u += nblk * 8) na_unit(P, layer, u, lane, rpl, vb);
    } else {
      for (int u = bid * 8 + wave; u < 16384; u += nblk * 8) na_unit(P, layer, u, lane, rpl, vb);
      for (int u = bid * 8 + wave; u < 4096; u += nblk * 8) lru_unit<false>(P, layer, u, lane);
    }
  }
}
DEVI void ph_mix2(KP P, int layer, int bid, int nblk, LAS unsigned char* lds) {
  s5_g2(P, layer, bid, nblk, lds);
  int t = tidx(), lane = t & 63, wave = t >> 6;
  for (int u = bid * 8 + wave; u < 4096; u += nblk * 8) lru_unit<true>(P, layer, u, lane);
}


#define XB_TMO      128
#define XB_XCNT(j)  (256  + 64 * (j))
#define XB_XSUB(j)  (1280 + 64 * (j))
#define XB_XGEN(j)  (2304 + 64 * (j))
#define XB_TOP      3328
#define XB_TOPGEN   3392
#define XCD_BAR_WORDS 3456
#define XB_SPIN_CAP (1u << 18)
DEVI unsigned xb_ld(unsigned* p) { return __hip_atomic_load(p, __ATOMIC_RELAXED, __HIP_MEMORY_SCOPE_AGENT); }
DEVI unsigned xb_add(unsigned* p, unsigned v) { return __hip_atomic_fetch_add(p, v, __ATOMIC_RELAXED, __HIP_MEMORY_SCOPE_AGENT); }
DEVI unsigned xb_xcc_id() { return (unsigned)__builtin_amdgcn_s_getreg((3 << 11) | 20) & 0xFu; }
#define XB_SPIN(cond, bar) do { unsigned _sp = 0; while (cond) { __builtin_amdgcn_s_sleep(1); \
    if ((++_sp & 255u) == 0u) { if (xb_ld(&(bar)[XB_TMO])) break; if (_sp > XB_SPIN_CAP) { atomicAdd(&(bar)[XB_TMO], 1u); break; } } } } while (0)
DEVI void xcd_barrier_complete(unsigned* bar, unsigned x, unsigned& nloc, unsigned& nx) {
  const unsigned G = gridDim.x;
  unsigned sum, cnt, mine, sp = 0u;
  for (;;) {
    sum = 0u; cnt = 0u; mine = 0u;
#pragma unroll
    for (unsigned j = 0; j < 16; ++j) { const unsigned c = xb_ld(&bar[XB_XCNT(j)]); sum += c; cnt += (c > 0u) ? 1u : 0u; mine = (j == x) ? c : mine; }
    if (sum == G) break;
    __builtin_amdgcn_s_sleep(1);
    if ((++sp & 255u) == 0u) { if (xb_ld(&bar[XB_TMO])) break; if (sp > XB_SPIN_CAP) { atomicAdd(&bar[XB_TMO], 1u); break; } }
  }
  nloc = mine > 0u ? mine : 1u; nx = cnt > 0u ? cnt : 1u;
}
DEVI void xcd_barrier(unsigned* bar, volatile LAS unsigned* st) {
  asm volatile("s_waitcnt vmcnt(0)" ::: "memory");
  __syncthreads();
  if (threadIdx.x == 0) {
    const unsigned x = xb_xcc_id();
    __builtin_amdgcn_s_waitcnt(0);
    unsigned nloc = st[0], nx = st[1];
    if (nloc == 0u) { xcd_barrier_complete(bar, x, nloc, nx); st[0] = nloc; st[1] = nx; }
    const unsigned old = xb_add(&bar[XB_XSUB(x)], 1u);
    const unsigned gen = old / nloc;
    if (old + 1u == (gen + 1u) * nloc) {
      __builtin_amdgcn_fence(__ATOMIC_RELEASE, "agent");
      asm volatile("s_waitcnt vmcnt(0)" ::: "memory");
      const unsigned og = xb_add(&bar[XB_TOP], 1u);
      const unsigned tg = og / nx;
      if (og + 1u == (tg + 1u) * nx) xb_add(&bar[XB_TOPGEN], 1u);
      else XB_SPIN(xb_ld(&bar[XB_TOPGEN]) == tg, bar);
      __builtin_amdgcn_fence(__ATOMIC_ACQUIRE, "agent");
      xb_add(&bar[XB_XGEN(x)], 1u);
      asm volatile("s_waitcnt vmcnt(0)" ::: "memory");
    } else {
      XB_SPIN(xb_ld(&bar[XB_XGEN(x)]) == gen, bar);
      __builtin_amdgcn_fence(__ATOMIC_ACQUIRE, "agent");
      asm volatile("s_waitcnt vmcnt(0)" ::: "memory");
    }
  }
  __syncthreads();
}

constexpr int NPH = 18;
#ifndef PHMASK
#define PHMASK 0x1ff
#endif
template <int PH>
DEVI void run_ph(LAS unsigned char* lds, unsigned char* shm) {
  constexpr int layer = PH / 9, s = PH % 9;
  int bid = blockIdx.x, nblk = gridDim.x;
  KP P = getP();
  if constexpr (s == 0 && (PHMASK & 1)) {
    if (layer == 0) ph_wprep(P, bid, nblk, reinterpret_cast<float(*)[65]>(shm));
    ph_s5pre1(P, layer, bid, nblk, lds);
    ph_rmsnorm(P, layer, bid, nblk);
  }
  if constexpr (s == 1 && (PHMASK & 2)) {
    ph_s5pre2(P, bid, nblk);
    ph_gemm1(P, layer, bid, nblk, lds);
  }
  if constexpr (s == 2 && (PHMASK & 4)) ph_mix1(P, layer, bid, nblk, lds);
  if constexpr (s == 3 && (PHMASK & 8)) {
    ph_lru_carry(P, bid, nblk);
    ph_s5_carry(P, layer, bid, nblk);
  }
  if constexpr (s == 4 && (PHMASK & 16)) ph_mix2(P, layer, bid, nblk, lds);
  if constexpr (s == 5 && (PHMASK & 32)) ph_glu(P, layer, bid, nblk, lds);
  if constexpr (s == 6 && (PHMASK & 64)) ph_merge(P, layer, bid, nblk, lds);
  if constexpr (s == 7 && (PHMASK & 128)) ph_wout(P, layer, bid, nblk, lds);
  if constexpr (s == 8 && (PHMASK & 256)) ph_ple(P, layer, bid, nblk, lds);
}
__global__ void __launch_bounds__(512) mega(Params P_unused) {
  extern __shared__ __attribute__((aligned(16))) unsigned char shm[];
  LAS unsigned char* lds = (LAS unsigned char*)shm;
  cg::grid_group grid = cg::this_grid();
  volatile LAS unsigned* st = (volatile LAS unsigned*)(lds + pg8::STAGE_BYTES);
  if (threadIdx.x == 0) {
    st[0] = 0u; st[1] = 0u;
    KP Pq = getP();
    (void)xb_add(&Pq->bar[XB_XCNT(xb_xcc_id())], 1u);
  }
  __syncthreads();
#define RP(n) run_ph<n>(lds, shm)
#define GS() do { KP Pq = getP(); xcd_barrier(Pq->bar, st); } while (0)
  RP(0); grid.sync(); RP(1); GS(); RP(2); GS(); RP(3); GS(); RP(4); GS(); RP(5); GS();
  RP(6); GS(); RP(7); GS(); RP(8); GS();
  RP(9); GS(); RP(10); GS(); RP(11); GS(); RP(12); GS(); RP(13); GS(); RP(14); GS();
  RP(15); GS(); RP(16); GS(); RP(17);
#undef RP
#undef GS
}

extern "C" void kernel_launch(void* const* d_in, const int* in_sizes, int n_in, void* d_out, int out_size, void* d_ws,
                              size_t ws_size, hipStream_t stream) {
  Params P{};
  const float** pf = reinterpret_cast<const float**>(&P);
  for (int i = 0; i < 30; ++i) pf[i] = (const float*)d_in[i];
  P.out = (float*)d_out;
  char* w = (char*)d_ws;
  size_t off = 0;
  auto take = [&](size_t bytes) {
    char* r = w + off;
    off += (bytes + 255) & ~(size_t)255;
    return r;
  };
  P.wt_in = (u16*)take((size_t)2 * 9216 * 1024 * 2);
  P.wt_br = (u16*)take((size_t)8 * 1024 * 512 * 2);
  P.wt_out = (u16*)take((size_t)2 * 1024 * 1024 * 2);
  P.wt_pg = (u16*)take((size_t)2 * 1024 * 1024 * 2);
  P.wt_pp = (u16*)take((size_t)2 * 1024 * 256 * 2);
  P.wt_glu = (u16*)take((size_t)2 * 512 * 512 * 2);
  P.wt_pool = (u16*)take((size_t)8 * 128 * 128 * 2);
  P.wt_lr = (u16*)take((size_t)32 * 64 * 64 * 2);
  P.wt_li = (u16*)take((size_t)32 * 64 * 64 * 2);
  P.hn = (u16*)take((size_t)T * 1024 * 2);
  P.z = (u16*)take((size_t)T * NZ * 2);
  P.ub = (u16*)take((size_t)T * 512 * 2);
  P.w1 = (u16*)take((size_t)32 * 256 * 512 * 2);
  P.bg2 = (u16*)take((size_t)32 * 512 * 768 * 2);
  P.ecar = (u16*)take((size_t)32 * 1024 * 256 * 2);
  P.ktab = (float*)take((size_t)32 * 2 * 32 * 256 * 4);
  P.lagg = (float*)take((size_t)8 * 64 * 2 * 512 * 2 * 4);
  P.lcar = (float*)take((size_t)8 * 64 * 2 * 512 * 4);
  P.bar = (unsigned*)take((size_t)XCD_BAR_WORDS * 4);
  if (off > ws_size) {
    fprintf(stderr, "workspace too small: need %zu have %zu\n", off, ws_size);
    return;
  }
  static int grid_blocks = 0;
  if (!grid_blocks) {
    int dev = 0, cus = 0, per_cu = 0;
    (void)hipGetDevice(&dev);
    (void)hipDeviceGetAttribute(&cus, hipDeviceAttributeMultiprocessorCount, dev);
    (void)hipFuncSetAttribute((const void*)mega, hipFuncAttributeMaxDynamicSharedMemorySize, pg8::STAGE_BYTES + 16);
    (void)hipOccupancyMaxActiveBlocksPerMultiprocessor(&per_cu, mega, NT, pg8::STAGE_BYTES + 16);
    if (per_cu > 1) per_cu = 1;
    grid_blocks = cus * per_cu;
  }
  void* args[] = {&P};
  (void)hipMemsetAsync(P.bar, 0, (size_t)XCD_BAR_WORDS * 4, stream);
  hipError_t e = hipLaunchCooperativeKernel((void*)mega, dim3(grid_blocks), dim3(NT), args, pg8::STAGE_BYTES + 16, stream);
  if (e != hipSuccess) fprintf(stderr, "cooperative launch failed: %s (grid %d)\n", hipGetErrorString(e), grid_blocks);
}
```
